# Optimizing an MI355X kernel written in HIP

```python
import jax, jax.numpy as jnp
from jax import lax
import numpy as np

D_MODEL = 1024
BATCH = 1
SEQ = 16384
DEPTH = 1

EPS = 1e-6
ROPE_THETA = 500000.0
ROT_FRAC = 4
GLA_HEADS = 4
GLA_DK = 64
GLA_DV = 128
GLA_GATE_RANK = 16
GLA_TAU = 16.0
GLA_CHUNK = 64
DSA_HEADS = 8
DSA_HD = 64
IDX_HEADS = 8
IDX_DIM = 64
DSA_TOPK_MAX = 256
Q_BLOCK = 128
N_GROUPS = 4
EXPERTS_PER_GROUP = 8
N_EXPERTS = N_GROUPS * EXPERTS_PER_GROUP
EXPERT_TOPK = 2
D_EXPERT = D_MODEL // 4
N_BRANCHES = 2
N_MOD = 6

GLA_QK = GLA_HEADS * GLA_DK
GLA_V = GLA_HEADS * GLA_DV
DSA_W = DSA_HEADS * DSA_HD
IDX_Q = IDX_HEADS * IDX_DIM
SPLIT_SIZES = (GLA_QK, GLA_QK, GLA_V, GLA_V, GLA_GATE_RANK,
               DSA_W, DSA_W, DSA_W, IDX_Q, IDX_DIM, IDX_HEADS,
               N_BRANCHES * D_MODEL)
D_IN = sum(SPLIT_SIZES)

kernel_name = "hybrid_gla_dsa_hmoe_block"


def rmsnorm(x, g):
    x32 = x.astype(jnp.float32)
    y = x32 * lax.rsqrt(jnp.mean(x32 * x32, axis=-1, keepdims=True) + EPS)
    return (y * g.astype(jnp.float32)).astype(x.dtype)


def layernorm(x, g):
    x32 = x.astype(jnp.float32)
    mu = jnp.mean(x32, axis=-1, keepdims=True)
    xc = x32 - mu
    y = xc * lax.rsqrt(jnp.mean(xc * xc, axis=-1, keepdims=True) + EPS)
    return (y * g.astype(jnp.float32)).astype(x.dtype)


def rope_partial(x, pos):
    hd = x.shape[-1]
    rot = hd // ROT_FRAC
    half = rot // 2
    freqs = jnp.power(jnp.float32(ROPE_THETA), -jnp.arange(half, dtype=jnp.float32) * 2.0 / rot)
    ang = pos.astype(jnp.float32)[:, :, None, None] * freqs
    cos, sin = jnp.cos(ang), jnp.sin(ang)
    x32 = x.astype(jnp.float32)
    x1, x2 = x32[..., :half], x32[..., half:rot]
    out = jnp.concatenate([x1 * cos - x2 * sin, x1 * sin + x2 * cos, x32[..., rot:]], axis=-1)
    return out.astype(x.dtype)


def gla_chunked(q, k, v, la):
    B, S, H, dk = q.shape
    dv = v.shape[-1]
    C = GLA_CHUNK
    N = S // C

    def to_chunks(t):
        return t.astype(jnp.float32).reshape(B, N, C, H, t.shape[-1]).transpose(1, 0, 3, 2, 4)

    causal = jnp.tril(jnp.ones((C, C), dtype=bool))

    def step(state, inp):
        qc, kc, vc, lac = inp
        b = jnp.cumsum(lac, axis=2)
        o_inter = jnp.einsum('bhtd,bhdv->bhtv', qc * jnp.exp(b), state)
        diff = b[:, :, :, None, :] - b[:, :, None, :, :]
        decay = jnp.exp(jnp.where(causal[:, :, None], diff, -jnp.inf))
        scores = jnp.einsum('bhtd,bhsd,bhtsd->bhts', qc, kc, decay)
        o = o_inter + jnp.einsum('bhts,bhsv->bhtv', scores, vc)
        b_last = b[:, :, -1:, :]
        state = (jnp.exp(b_last[:, :, 0, :])[..., None] * state
                 + jnp.einsum('bhsd,bhsv->bhdv', kc * jnp.exp(b_last - b), vc))
        return state, o

    s0 = jnp.zeros((B, H, dk, dv), jnp.float32)
    _, o = lax.scan(step, s0, (to_chunks(q), to_chunks(k), to_chunks(v), to_chunks(la)))
    return o.transpose(1, 0, 3, 2, 4).reshape(B, S, H, dv).astype(q.dtype)


def dsa_attention(q, k, v, qi, ki, wi):
    B, S, H, hd = q.shape
    topk = min(DSA_TOPK_MAX, S // 4)
    nb = S // Q_BLOCK

    def blocks(t):
        return t.reshape((B, nb, Q_BLOCK) + t.shape[2:]).swapaxes(0, 1)

    qpos = jnp.arange(S, dtype=jnp.int32).reshape(nb, Q_BLOCK)
    kpos = jnp.arange(S, dtype=jnp.int32)
    ki32 = ki.astype(jnp.float32)

    def one_block(inp):
        qb, qib, wib, tb = inp
        logits = jnp.einsum('bqhd,bsd->bqhs', qib.astype(jnp.float32), ki32) * (IDX_DIM ** -0.5)
        idx_score = jnp.einsum('bqhs,bqh->bqs', jax.nn.relu(logits), wib.astype(jnp.float32))
        visible = kpos[None, :] <= tb[:, None]
        idx_score = jnp.where(visible[None], idx_score, -jnp.inf)
        _, sel = lax.top_k(idx_score, topk)
        k_sel = jax.vmap(lambda kk, ii: kk[ii])(k, sel)
        v_sel = jax.vmap(lambda vv, ii: vv[ii])(v, sel)
        valid = sel <= tb[None, :, None]
        s = jnp.einsum('bqhd,bqkhd->bhqk', qb.astype(jnp.float32), k_sel.astype(jnp.float32)) * (hd ** -0.5)
        s = jnp.where(valid[:, None], s, -jnp.inf)
        p = jax.nn.softmax(s, axis=-1)
        return jnp.einsum('bhqk,bqkhd->bqhd', p, v_sel.astype(jnp.float32)).astype(q.dtype)

    out = lax.map(one_block, (blocks(q), blocks(qi), blocks(wi), qpos))
    return out.swapaxes(0, 1).reshape(B, S, H, hd)


def hier_moe(h, w_rg, b_rg, w_re, b_re, w_g, w_u, w_d):
    B, S, D = h.shape
    T = B * S
    ht = h.reshape(T, D)
    g_prob = jax.nn.softmax((ht @ w_rg + b_rg).astype(jnp.float32), axis=-1)
    g_sel = jnp.argmax(g_prob, axis=-1)
    p_g = jnp.take_along_axis(g_prob, g_sel[:, None], axis=1)[:, 0]
    e_logits = (ht @ w_re + b_re).astype(jnp.float32).reshape(T, N_GROUPS, EXPERTS_PER_GROUP)
    e_in = jnp.take_along_axis(e_logits, g_sel[:, None, None], axis=1)[:, 0]
    e_prob = jax.nn.softmax(e_in, axis=-1)
    top_p, top_i = lax.top_k(e_prob, EXPERT_TOPK)
    top_p = top_p / jnp.sum(top_p, axis=-1, keepdims=True)
    eid = g_sel[:, None] * EXPERTS_PER_GROUP + top_i
    combine = jnp.sum(jax.nn.one_hot(eid, N_EXPERTS, dtype=jnp.float32)
                      * (p_g[:, None] * top_p)[..., None], axis=1)
    hg = jnp.einsum('td,edf->tef', ht, w_g)
    hu = jnp.einsum('td,edf->tef', ht, w_u)
    act = jax.nn.silu(hg) * hu * combine[..., None].astype(hg.dtype)
    y = jnp.einsum('tef,efd->td', act, w_d)
    return y.reshape(B, S, D)


def setup_inputs(seed: int = 0) -> dict:
    key = jax.random.key(seed)
    ks = jax.random.split(key, 32)
    D = D_MODEL

    def nrm(k, shape, scale):
        return jax.random.normal(k, shape, jnp.float32) * scale

    def gain(k, n):
        return 1.0 + 0.02 * jax.random.normal(k, (DEPTH, n), jnp.float32)

    return {
        "x": nrm(ks[0], (BATCH, SEQ, D), 1.0),
        "c": nrm(ks[1], (BATCH, D), 1.0),
        "positions": jnp.broadcast_to(jnp.arange(SEQ, dtype=jnp.int32), (BATCH, SEQ)),
        "w_ada": nrm(ks[2], (DEPTH, D, N_MOD * D), 0.2 * D ** -0.5),
        "b_ada": nrm(ks[3], (DEPTH, N_MOD * D), 0.02),
        "g_pre_mix": gain(ks[4], D),
        "g_post_mix": gain(ks[5], D),
        "g_pre_ffn": gain(ks[6], D),
        "g_post_ffn": gain(ks[7], D),
        "w_in": nrm(ks[8], (DEPTH, D, D_IN), D ** -0.5),
        "w_gla_a2": nrm(ks[9], (DEPTH, GLA_GATE_RANK, GLA_QK), GLA_GATE_RANK ** -0.5),
        "b_gla_a": nrm(ks[10], (DEPTH, GLA_QK), 0.1),
        "g_gla_out": gain(ks[11], GLA_DV),
        "g_idx_k": gain(ks[12], IDX_DIM),
        "w_proj_gla": nrm(ks[13], (DEPTH, GLA_V, D), GLA_V ** -0.5),
        "w_proj_dsa": nrm(ks[14], (DEPTH, DSA_W, D), DSA_W ** -0.5),
        "w_out": nrm(ks[15], (DEPTH, D, D), D ** -0.5),
        "w_router_g": nrm(ks[16], (DEPTH, D, N_GROUPS), D ** -0.5),
        "b_router_g": nrm(ks[17], (DEPTH, N_GROUPS), 0.01),
        "w_router_e": nrm(ks[18], (DEPTH, D, N_EXPERTS), D ** -0.5),
        "b_router_e": nrm(ks[19], (DEPTH, N_EXPERTS), 0.01),
        "w_e_gate": nrm(ks[20], (DEPTH, N_EXPERTS, D, D_EXPERT), D ** -0.5),
        "w_e_up": nrm(ks[21], (DEPTH, N_EXPERTS, D, D_EXPERT), D ** -0.5),
        "w_e_down": nrm(ks[22], (DEPTH, N_EXPERTS, D_EXPERT, D), D_EXPERT ** -0.5),
    }


def reference(x, c, positions, w_ada, b_ada, g_pre_mix, g_post_mix, g_pre_ffn, g_post_ffn,
              w_in, w_gla_a2, b_gla_a, g_gla_out, g_idx_k, w_proj_gla, w_proj_dsa, w_out,
              w_router_g, b_router_g, w_router_e, b_router_e, w_e_gate, w_e_up, w_e_down):
    B, S, D = x.shape
    offsets = [int(o) for o in np.cumsum(SPLIT_SIZES)[:-1]]
    for l in range(DEPTH):
        mod = (jax.nn.silu(c) @ w_ada[l] + b_ada[l]).reshape(B, N_MOD, D)
        shift_m, scale_m, gate_m, shift_f, scale_f, gate_f = [mod[:, i][:, None, :] for i in range(N_MOD)]

        h = rmsnorm(x, g_pre_mix[l]) * (1.0 + scale_m) + shift_m
        proj = h @ w_in[l]
        (gq, gk, gv, gg, ga_low, dq, dk, dv, iq, ik, iw, bg) = jnp.split(proj, offsets, axis=-1)

        q_a = gq.reshape(B, S, GLA_HEADS, GLA_DK) * (GLA_DK ** -0.5)
        k_a = gk.reshape(B, S, GLA_HEADS, GLA_DK)
        v_a = gv.reshape(B, S, GLA_HEADS, GLA_DV)
        la = jax.nn.log_sigmoid((ga_low @ w_gla_a2[l] + b_gla_a[l]).astype(jnp.float32)) / GLA_TAU
        o_a = gla_chunked(q_a, k_a, v_a, la.reshape(B, S, GLA_HEADS, GLA_DK))
        o_a = rmsnorm(o_a, g_gla_out[l]) * jax.nn.silu(gg.reshape(B, S, GLA_HEADS, GLA_DV))
        y_gla = o_a.reshape(B, S, GLA_V) @ w_proj_gla[l]

        q_b = rope_partial(dq.reshape(B, S, DSA_HEADS, DSA_HD), positions)
        k_b = rope_partial(dk.reshape(B, S, DSA_HEADS, DSA_HD), positions)
        v_b = dv.reshape(B, S, DSA_HEADS, DSA_HD)
        qi = rope_partial(iq.reshape(B, S, IDX_HEADS, IDX_DIM), positions)
        ki = rope_partial(layernorm(ik, g_idx_k[l])[:, :, None, :], positions)[:, :, 0, :]
        wi = iw * (IDX_HEADS ** -0.5)
        o_b = dsa_attention(q_b, k_b, v_b, qi, ki, wi)
        y_dsa = o_b.reshape(B, S, DSA_W) @ w_proj_dsa[l]

        gates = jax.nn.sigmoid(bg.reshape(B, S, N_BRANCHES, D))
        mix = gates[:, :, 0] * y_gla + gates[:, :, 1] * y_dsa
        out = mix @ w_out[l]
        x = x + gate_m * rmsnorm(out, g_post_mix[l])

        h = rmsnorm(x, g_pre_ffn[l]) * (1.0 + scale_f) + shift_f
        y = hier_moe(h, w_router_g[l], b_router_g[l], w_router_e[l], b_router_e[l],
                     w_e_gate[l], w_e_up[l], w_e_down[l])
        x = x + gate_f * rmsnorm(y, g_post_ffn[l])
    return x
```

```cpp
#include <hip/hip_runtime.h>
#include <hip/hip_cooperative_groups.h>
#include <cstdio>
#include <cstdint>
namespace cg = cooperative_groups;

#define DEVI __device__ __forceinline__
typedef unsigned short bf16_t;
typedef short bf16x8 __attribute__((ext_vector_type(8)));
typedef float f32x4 __attribute__((ext_vector_type(4)));
typedef float f32x16 __attribute__((ext_vector_type(16)));
typedef unsigned u32x4 __attribute__((ext_vector_type(4)));
typedef unsigned u32x2 __attribute__((ext_vector_type(2)));

constexpr int S = 16384, D = 1024, DIN = 5720;
constexpr int LDP = 5760;
constexpr int C_GQ = 0, C_GK = 256, C_GV = 512, C_GG = 1024, C_DQ = 1536, C_DK = 2048, C_DV = 2560, C_IQ = 3072, C_BG = 3584, C_IK = 5632, C_GA = 5696, C_IW = 5712;
constexpr int C_OA = C_GG, C_OB = C_DQ;
constexpr int C_XM = 1024;
constexpr int C_H2 = 2048;
constexpr int C_Y = 3072;
constexpr float EPS = 1e-6f;
constexpr int NEXP = 32, DEXP = 256;

constexpr size_t WS_P    = 0;
constexpr size_t WS_WGU  = WS_P + (size_t)S * LDP * 2;
constexpr size_t WS_WD   = WS_WGU + (size_t)NEXP * 512 * 1024 * 2;
constexpr size_t WS_SEL  = WS_WD + (size_t)NEXP * 1024 * 256 * 2;
constexpr size_t WS_KI   = WS_SEL + (size_t)16 * 1024 * 1024;
constexpr size_t WS_AUX  = WS_KI + (size_t)S * 64 * 2;
constexpr size_t WS_ROPE = WS_AUX + (size_t)S * 32 * 4;
constexpr size_t WS_LIST = WS_ROPE + (size_t)S * 8 * 8;
constexpr size_t WS_MOD  = WS_LIST + (size_t)NEXP * S * 4;
constexpr size_t WS_SELC = WS_MOD + 6144 * 4;
constexpr size_t WS_CW   = WS_SELC + (size_t)S * 4;
constexpr size_t WS_CNT  = WS_CW + (size_t)S * 2 * 4;
constexpr size_t WS_BAR  = WS_CNT + 8192;
constexpr size_t WS_WRT  = WS_BAR + 3456 * 4;
constexpr size_t WS_SKT  = WS_WRT + 48 * 1024 * 4;
constexpr size_t WS_END  = WS_SKT + (size_t)8 * S * 2;
constexpr size_t DO_H    = 0;
constexpr size_t DO_WIN  = (size_t)32 * 1024 * 1024;
constexpr size_t DO_WPG  = (size_t)44 * 1024 * 1024;
constexpr size_t DO_WPD  = (size_t)45 * 1024 * 1024;
constexpr size_t DO_WOUT = (size_t)46 * 1024 * 1024;
constexpr size_t DO_GD   = (size_t)52 * 1024 * 1024;

constexpr int NT = 256;
constexpr int LDS_BYTES = 77824;

struct Params {
    const float* x; const float* c; const int* pos; const float* w_ada; const float* b_ada;
    const float* g_pre_mix; const float* g_post_mix; const float* g_pre_ffn; const float* g_post_ffn;
    const float* w_in; const float* w_gla_a2; const float* b_gla_a; const float* g_gla_out; const float* g_idx_k;
    const float* w_proj_gla; const float* w_proj_dsa; const float* w_out;
    const float* w_rg; const float* b_rg; const float* w_re; const float* b_re;
    const float* w_eg; const float* w_eu; const float* w_ed;
    float* out; unsigned char* ws;
};

typedef __bf16 bf16v2_t __attribute__((ext_vector_type(2)));
typedef float f32x2_t __attribute__((ext_vector_type(2)));
typedef short s16x2_t __attribute__((ext_vector_type(2)));
DEVI unsigned pk2(float lo, float hi) { f32x2_t v = {lo, hi}; bf16v2_t r = __builtin_convertvector(v, bf16v2_t); return __builtin_bit_cast(unsigned, r); }
DEVI unsigned f2bf(float f) { return pk2(f, 0.f) & 0xffffu; }
DEVI float bf2f(unsigned h) { return __uint_as_float(h << 16); }
DEVI unsigned relu2_bf16(unsigned x) { s16x2_t v = __builtin_bit_cast(s16x2_t, x); const s16x2_t z = {0, 0}; v = __builtin_elementwise_max(v, z); return __builtin_bit_cast(unsigned, v); }
extern "C" __device__ unsigned __ockl_wfred_max_u32(unsigned);
DEVI float bflo(unsigned w) { return __uint_as_float(w << 16); }
DEVI float bfhi(unsigned w) { return __uint_as_float(w & 0xffff0000u); }
extern "C" __device__ float __ockl_wfred_add_f32(float);
DEVI float wave_sum(float v) { return __ockl_wfred_add_f32(v); }
DEVI float sigmoidf_(float z) { return __builtin_amdgcn_rcpf(1.0f + __builtin_amdgcn_exp2f(-1.4426950408889634f * z)); }
DEVI float siluf_(float z) { return z * __builtin_amdgcn_rcpf(1.0f + __builtin_amdgcn_exp2f(-1.4426950408889634f * z)); }

DEVI int tile_off(int row, int chunk) { return row * 128 + ((chunk ^ (row & 7)) << 4); }

DEVI int gemm_kc(int tid) { return ((tid & 7) ^ ((tid >> 3) & 7)) * 8; }
typedef __attribute__((address_space(3))) unsigned lds_u32_t;
DEVI void gemm128(f32x4 (&acc)[4][4], const bf16_t* const (&ap)[4], const bf16_t* const (&bp)[4], int KT, unsigned char* lds, int tid) {
    const int lane = tid & 63, wave = __builtin_amdgcn_readfirstlane(tid >> 6), wr = wave >> 1, wc = wave & 1;
#pragma unroll
    for (int p = 0; p < 4; ++p) {
        __builtin_amdgcn_global_load_lds((const unsigned*)ap[p], (lds_u32_t*)(lds + (p * 256 + wave * 64) * 16), 16, 0, 0);
        __builtin_amdgcn_global_load_lds((const unsigned*)bp[p], (lds_u32_t*)(lds + 16384 + (p * 256 + wave * 64) * 16), 16, 0, 0);
    }
    __syncthreads();
    for (int kt = 0; kt < KT; ++kt) {
        unsigned char* As = lds + (kt & 1) * 32768;
        unsigned char* Bs = As + 16384;
        if (kt + 1 < KT) {
            unsigned char* An = lds + ((kt + 1) & 1) * 32768;
#pragma unroll
            for (int p = 0; p < 4; ++p) {
                __builtin_amdgcn_global_load_lds((const unsigned*)(ap[p] + (kt + 1) * 64), (lds_u32_t*)(An + (p * 256 + wave * 64) * 16), 16, 0, 0);
                __builtin_amdgcn_global_load_lds((const unsigned*)(bp[p] + (kt + 1) * 64), (lds_u32_t*)(An + 16384 + (p * 256 + wave * 64) * 16), 16, 0, 0);
            }
        }
#pragma unroll
        for (int ks = 0; ks < 2; ++ks) {
            bf16x8 a[4], b[4];
#pragma unroll
            for (int m = 0; m < 4; ++m) a[m] = *(const bf16x8*)(As + tile_off(wr * 64 + m * 16 + (lane & 15), ks * 4 + (lane >> 4)));
#pragma unroll
            for (int n = 0; n < 4; ++n) b[n] = *(const bf16x8*)(Bs + tile_off(wc * 64 + n * 16 + (lane & 15), ks * 4 + (lane >> 4)));
#pragma unroll
            for (int m = 0; m < 4; ++m)
#pragma unroll
                for (int n = 0; n < 4; ++n) acc[m][n] = __builtin_amdgcn_mfma_f32_16x16x32_bf16(b[n], a[m], acc[m][n], 0, 0, 0);
        }
        __syncthreads();
    }
}

DEVI void gemm128p(f32x4 (&acc)[4][4], const bf16_t* const (&ap)[4], const bf16_t* const (&bp)[4], int KT, unsigned char* lds, int tid,
                   int& par, bool pre, const bf16_t* const (&nap)[4], const bf16_t* const (&nbp)[4], bool has_next) {
    const int lane = tid & 63, wave = __builtin_amdgcn_readfirstlane(tid >> 6), wr = wave >> 1, wc = wave & 1;
    if (!pre) {
        unsigned char* A0 = lds + par * 32768;
#pragma unroll
        for (int p = 0; p < 4; ++p) {
            __builtin_amdgcn_global_load_lds((const unsigned*)ap[p], (lds_u32_t*)(A0 + (p * 256 + wave * 64) * 16), 16, 0, 0);
            __builtin_amdgcn_global_load_lds((const unsigned*)bp[p], (lds_u32_t*)(A0 + 16384 + (p * 256 + wave * 64) * 16), 16, 0, 0);
        }
        __syncthreads();
    }
    for (int kt = 0; kt < KT; ++kt) {
        const int cur = (par + kt) & 1;
        unsigned char* As = lds + cur * 32768;
        unsigned char* Bs = As + 16384;
        unsigned char* An = lds + (cur ^ 1) * 32768;
        if (kt + 1 < KT) {
#pragma unroll
            for (int p = 0; p < 4; ++p) {
                __builtin_amdgcn_global_load_lds((const unsigned*)(ap[p] + (kt + 1) * 64), (lds_u32_t*)(An + (p * 256 + wave * 64) * 16), 16, 0, 0);
                __builtin_amdgcn_global_load_lds((const unsigned*)(bp[p] + (kt + 1) * 64), (lds_u32_t*)(An + 16384 + (p * 256 + wave * 64) * 16), 16, 0, 0);
            }
        } else if (has_next) {
#pragma unroll
            for (int p = 0; p < 4; ++p) {
                __builtin_amdgcn_global_load_lds((const unsigned*)nap[p], (lds_u32_t*)(An + (p * 256 + wave * 64) * 16), 16, 0, 0);
                __builtin_amdgcn_global_load_lds((const unsigned*)nbp[p], (lds_u32_t*)(An + 16384 + (p * 256 + wave * 64) * 16), 16, 0, 0);
            }
        }
#pragma unroll
        for (int ks = 0; ks < 2; ++ks) {
            bf16x8 a[4], b[4];
#pragma unroll
            for (int m = 0; m < 4; ++m) a[m] = *(const bf16x8*)(As + tile_off(wr * 64 + m * 16 + (lane & 15), ks * 4 + (lane >> 4)));
#pragma unroll
            for (int n = 0; n < 4; ++n) b[n] = *(const bf16x8*)(Bs + tile_off(wc * 64 + n * 16 + (lane & 15), ks * 4 + (lane >> 4)));
#pragma unroll
            for (int m = 0; m < 4; ++m)
#pragma unroll
                for (int n = 0; n < 4; ++n) acc[m][n] = __builtin_amdgcn_mfma_f32_16x16x32_bf16(b[n], a[m], acc[m][n], 0, 0, 0);
        }
        __syncthreads();
    }
    par = (par + KT) & 1;
}

DEVI void zero_acc(f32x4 (&acc)[4][4]) {
#pragma unroll
    for (int m = 0; m < 4; ++m)
#pragma unroll
        for (int n = 0; n < 4; ++n) acc[m][n] = (f32x4){0.f, 0.f, 0.f, 0.f};
}

DEVI void gemm256b(f32x4 (&acc)[8][4], const bf16_t* a0, const bf16_t* b0, int lda, int ldb, int KT  , unsigned char* lds, int tid,
                   bool pre, int dna, int dnb, bool has_next) {
    const int lane = tid & 63, wave = __builtin_amdgcn_readfirstlane(tid >> 6), wr = wave >> 1, wc = wave & 1;
    auto issueA = [&](const bf16_t* src) {
#pragma unroll
        for (int p = 0; p < 8; ++p) __builtin_amdgcn_global_load_lds((const unsigned*)(src + (size_t)p * 32 * lda), (lds_u32_t*)(lds + (p * 256 + wave * 64) * 16), 16, 0, 0);
    };
    auto issueB = [&](const bf16_t* src, int buf) {
        unsigned char* Bn = lds + 32768 + buf * 16384;
#pragma unroll
        for (int p = 0; p < 4; ++p) __builtin_amdgcn_global_load_lds((const unsigned*)(src + (size_t)p * 32 * ldb), (lds_u32_t*)(Bn + (p * 256 + wave * 64) * 16), 16, 0, 0);
    };
    if (!pre) { issueA(a0); issueB(b0, 0); }
    for (int kt = 0; kt < KT; ++kt) {
        __syncthreads();
        if (kt + 1 < KT) issueB(b0 + (kt + 1) * 64, (kt + 1) & 1);
        const unsigned char* Bs = lds + 32768 + (kt & 1) * 16384;
        bf16x8 a[8], b[4];
#pragma unroll
        for (int m = 0; m < 8; ++m) a[m] = *(const bf16x8*)(lds + tile_off(wr * 128 + m * 16 + (lane & 15), lane >> 4));
#pragma unroll
        for (int n = 0; n < 4; ++n) b[n] = *(const bf16x8*)(Bs + tile_off(wc * 64 + n * 16 + (lane & 15), lane >> 4));
#pragma unroll
        for (int m = 0; m < 8; ++m)
#pragma unroll
            for (int n = 0; n < 4; ++n) acc[m][n] = __builtin_amdgcn_mfma_f32_16x16x32_bf16(b[n], a[m], acc[m][n], 0, 0, 0);
#pragma unroll
        for (int m = 0; m < 8; ++m) a[m] = *(const bf16x8*)(lds + tile_off(wr * 128 + m * 16 + (lane & 15), 4 + (lane >> 4)));
#pragma unroll
        for (int n = 0; n < 4; ++n) b[n] = *(const bf16x8*)(Bs + tile_off(wc * 64 + n * 16 + (lane & 15), 4 + (lane >> 4)));
        asm volatile("" ::: "memory");
        __builtin_amdgcn_s_waitcnt(0xC07F);
        __builtin_amdgcn_s_barrier();
        asm volatile("" ::: "memory");
        if (kt + 1 < KT) issueA(a0 + (kt + 1) * 64);
#pragma unroll
        for (int m = 0; m < 8; ++m)
#pragma unroll
            for (int n = 0; n < 4; ++n) acc[m][n] = __builtin_amdgcn_mfma_f32_16x16x32_bf16(b[n], a[m], acc[m][n], 0, 0, 0);
    }
    __syncthreads();
    if (has_next) { issueA(a0 + dna); issueB(b0 + dnb, 0); }
}

#define XB_TMO      128
#define XB_XCNT(j)  (256  + 64 * (j))
#define XB_XSUB(j)  (1280 + 64 * (j))
#define XB_XGEN(j)  (2304 + 64 * (j))
#define XB_TOP      3328
#define XB_TOPGEN   3392
#define XCD_BAR_WORDS 3456
#define XB_SPIN_CAP (1u << 20)
#define LAS __attribute__((address_space(3)))
DEVI unsigned xb_ld(unsigned* p)              { return __hip_atomic_load(p, __ATOMIC_RELAXED, __HIP_MEMORY_SCOPE_AGENT); }
DEVI unsigned xb_add(unsigned* p, unsigned v) { return __hip_atomic_fetch_add(p, v, __ATOMIC_RELAXED, __HIP_MEMORY_SCOPE_AGENT); }
DEVI unsigned xb_xcc_id() { return (unsigned)__builtin_amdgcn_s_getreg((3 << 11) | 20) & 0xFu; }
#define XB_SPIN(cond, bar) do { unsigned _sp = 0; while (cond) { __builtin_amdgcn_s_sleep(1); \
    if ((++_sp & 255u) == 0u) { if (xb_ld(&(bar)[XB_TMO])) break; if (_sp > XB_SPIN_CAP) { atomicAdd(&(bar)[XB_TMO], 1u); break; } } } } while (0)
struct XcdBarrier { unsigned* bar; unsigned x; volatile LAS unsigned* st; };
DEVI XcdBarrier xcd_barrier_post(unsigned* bar, volatile LAS unsigned* st) {
    XcdBarrier b; b.bar = bar; b.x = xb_xcc_id(); b.st = st;
    if (threadIdx.x == 0) (void)xb_add(&bar[XB_XCNT(b.x)], 1u);
    return b;
}
DEVI void xcd_barrier_complete(unsigned* bar, unsigned x, unsigned& nloc, unsigned& nx) {
    const unsigned G = gridDim.x * gridDim.y * gridDim.z;
    unsigned sum, cnt, mine, sp = 0u;
    for (;;) {
        sum = 0u; cnt = 0u; mine = 0u;
#pragma unroll
        for (unsigned j = 0; j < 16; ++j) { const unsigned c = xb_ld(&bar[XB_XCNT(j)]); sum += c; cnt += (c > 0u) ? 1u : 0u; mine = (j == x) ? c : mine; }
        if (sum == G) break;
        __builtin_amdgcn_s_sleep(1);
        if ((++sp & 255u) == 0u) { if (xb_ld(&bar[XB_TMO])) break; if (sp > XB_SPIN_CAP) { atomicAdd(&bar[XB_TMO], 1u); break; } }
    }
    nloc = mine > 0u ? mine : 1u; nx = cnt > 0u ? cnt : 1u;
}
DEVI void xcd_barrier(const XcdBarrier& b) {
    asm volatile("s_waitcnt vmcnt(0)" ::: "memory");
    __syncthreads();
    if (threadIdx.x == 0) {
        unsigned* bar = b.bar;
        __builtin_amdgcn_s_waitcnt(0);
        unsigned nloc = b.st[0], nx = b.st[1];
        if (nloc == 0u) { xcd_barrier_complete(bar, b.x, nloc, nx); b.st[0] = nloc; b.st[1] = nx; }
        const unsigned old = xb_add(&bar[XB_XSUB(b.x)], 1u);
        const unsigned gen = old / nloc;
        if (old + 1u == (gen + 1u) * nloc) {
            __builtin_amdgcn_fence(__ATOMIC_RELEASE, "agent");
            asm volatile("s_waitcnt vmcnt(0)" ::: "memory");
            const unsigned og = xb_add(&bar[XB_TOP], 1u);
            const unsigned tg = og / nx;
            if (og + 1u == (tg + 1u) * nx) xb_add(&bar[XB_TOPGEN], 1u);
            else XB_SPIN(xb_ld(&bar[XB_TOPGEN]) == tg, bar);
            __builtin_amdgcn_fence(__ATOMIC_ACQUIRE, "agent");
            xb_add(&bar[XB_XGEN(b.x)], 1u);
            asm volatile("s_waitcnt vmcnt(0)" ::: "memory");
        } else {
            XB_SPIN(xb_ld(&bar[XB_XGEN(b.x)]) == gen, bar);
            __builtin_amdgcn_fence(__ATOMIC_ACQUIRE, "agent");
            asm volatile("s_waitcnt vmcnt(0)" ::: "memory");
        }
    }
    __syncthreads();
}

DEVI int win_src_col(int n) {
    if (n < 1536) return n;
    if (n < 3584) return n + 16;
    if (n < 5632) return n + 88;
    if (n < 5696) return n - 5632 + 3600;
    if (n < 5712) return n - 5696 + 1536;
    if (n < 5720) return n - 5712 + 3664;
    return -1;
}

struct TDesc { const float* sp; int ld; bf16_t* dst; int ld_dst; int n0, k0; };
DEVI TDesc tile_desc(const Params& p, int it, int tid) {
    constexpr int T0 = 1440, T1 = T0 + 128, T2 = T1 + 128, T3 = T2 + 256, T4 = T3 + 4096;
    unsigned char* dout = (unsigned char*)p.out;
    TDesc d; const int nn = (tid & 15) * 4;
    if (it < T0) {
        d.n0 = (it >> 4) * 64; d.k0 = (it & 15) * 64; d.ld = DIN; d.dst = (bf16_t*)(dout + DO_WIN); d.ld_dst = 1024;
        const int sc = win_src_col(d.n0 + nn);
        d.sp = sc >= 0 ? p.w_in + sc : nullptr;
    } else if (it < T2) {
        const bool second = it >= T1; const int j = it - (second ? T1 : T0);
        d.n0 = (j >> 3) * 64; d.k0 = (j & 7) * 64; d.ld = 1024; d.dst = (bf16_t*)(dout + (second ? DO_WPD : DO_WPG)); d.ld_dst = 512;
        d.sp = (second ? p.w_proj_dsa : p.w_proj_gla) + d.n0 + nn;
    } else if (it < T3) {
        const int j = it - T2;
        d.n0 = (j >> 4) * 64; d.k0 = (j & 15) * 64; d.ld = 1024; d.dst = (bf16_t*)(dout + DO_WOUT); d.ld_dst = 1024;
        d.sp = p.w_out + d.n0 + nn;
    } else if (it < T4) {
        const int j = it - T3, e = j >> 7, r = j & 127;
        d.n0 = (r >> 4) * 64; d.k0 = (r & 15) * 64; d.ld = 256; d.dst = (bf16_t*)(p.ws + WS_WGU) + (size_t)e * 512 * 1024; d.ld_dst = 1024;
        const int n = d.n0 + nn, ns = (n >> 4) & 3, f = (n >> 7) * 64 + ((n >> 6) & 1) * 32 + (ns >> 1) * 16 + (n & 15);
        d.sp = ((ns & 1) ? p.w_eu : p.w_eg) + (size_t)e * 1024 * 256 + f;
    } else {
        const int j = it - T4, e = j >> 6, r = j & 63;
        d.n0 = (r >> 2) * 64; d.k0 = (r & 3) * 64; d.ld = 1024; d.dst = (bf16_t*)(p.ws + WS_WD) + (size_t)e * 1024 * 256; d.ld_dst = 256;
        d.sp = p.w_ed + (size_t)e * 256 * 1024 + d.n0 + nn;
    }
    return d;
}
DEVI void tile_load(const TDesc& d, f32x4 (&v4)[4], int tid) {
#pragma unroll
    for (int i = 0; i < 4; ++i) v4[i] = d.sp ? *(const f32x4*)(d.sp + (size_t)(d.k0 + i * 16 + (tid >> 4)) * d.ld) : (f32x4){0.f, 0.f, 0.f, 0.f};
}
DEVI void tile_finish(const TDesc& d, const f32x4 (&v4)[4], float* tl  , int tid) {
    __syncthreads();
#pragma unroll
    for (int i = 0; i < 4; ++i) {
        const int kk = i * 16 + (tid >> 4), nn = (tid & 15) * 4;
        tl[kk * 65 + nn] = v4[i][0]; tl[kk * 65 + nn + 1] = v4[i][1]; tl[kk * 65 + nn + 2] = v4[i][2]; tl[kk * 65 + nn + 3] = v4[i][3];
    }
    __syncthreads();
#pragma unroll
    for (int p2 = 0; p2 < 2; ++p2) {
        const int nn = p2 * 32 + (tid >> 3), ch = tid & 7;
        float v[8];
#pragma unroll
        for (int j = 0; j < 8; ++j) v[j] = tl[(ch * 8 + j) * 65 + nn];
        u32x4 w; w.x = pk2(v[0], v[1]); w.y = pk2(v[2], v[3]); w.z = pk2(v[4], v[5]); w.w = pk2(v[6], v[7]);
        *(u32x4*)(d.dst + (size_t)(d.n0 + nn) * d.ld_dst + d.k0 + ch * 8) = w;
    }
}

static DEVI void phase0(const Params& p, unsigned char* lds, int tid) {
    float* tl = (float*)lds;
    const int nb = gridDim.x, b = blockIdx.x;
    unsigned char* dout = (unsigned char*)p.out;
    for (int it = b; it < 192; it += nb) {
        const int col = it * 32 + (tid & 31), kg = tid >> 5;
        float s = 0.f;
        for (int k0 = 0; k0 < 1024; k0 += 128) {
            float wv[16], cv[16];
#pragma unroll
            for (int j = 0; j < 16; ++j) { const int k = k0 + j * 8 + kg; wv[j] = p.w_ada[(size_t)k * 6144 + col]; cv[j] = p.c[k]; }
#pragma unroll
            for (int j = 0; j < 16; ++j) s += siluf_(cv[j]) * wv[j];
        }
        __syncthreads();
        tl[tid] = s;
        __syncthreads();
        if (tid < 32) {
            float t = 0.f;
#pragma unroll
            for (int g = 0; g < 8; ++g) t += tl[g * 32 + tid];
            ((float*)(p.ws + WS_MOD))[col] = t + p.b_ada[col];
            __threadfence();
        }
        if (it < 64) {
            __syncthreads();
            if (tid == 0) __hip_atomic_fetch_add((unsigned*)(p.ws + WS_CNT) + 1, 1u, __ATOMIC_RELEASE, __HIP_MEMORY_SCOPE_AGENT);
        }
    }
    for (int it = b; it < 192; it += nb) {
        const int e = it * 256 + tid, row = e >> 10, k = e & 1023;
        float v = 0.f;
        if (row < 4) v = p.w_rg[(size_t)k * 4 + row]; else if (row < 36) v = p.w_re[(size_t)k * 32 + (row - 4)];
        ((bf16_t*)(p.ws + WS_WRT))[e] = (bf16_t)(pk2(v, 0.f) & 0xffffu);
    }
    for (int it = b; it < 512; it += nb) {
        const int e = it * 256 + tid, t = e >> 3, i = e & 7;
        const double fr[8] = {1.0, 0.19392274474868576, 0.03760603093086393, 0.007292664737217109, 0.001414213562373095, 0.0002742481756762073, 5.318295896944988e-05, 1.031338537721246e-05};
        double f = fr[0];
#pragma unroll
        for (int q = 1; q < 8; ++q) f = (i == q) ? fr[q] : f;
        const float ang32 = (float)p.pos[t] * (float)f;
        const double rev = (double)ang32 * 0.15915494309189535;
        const float fracr = (float)(rev - floor(rev));
        float2 cs; cs.x = __builtin_amdgcn_cosf(fracr); cs.y = __builtin_amdgcn_sinf(fracr);
        ((float2*)(p.ws + WS_ROPE))[e] = cs;
    }
    constexpr int T5 = 1440 + 128 + 128 + 256 + 4096 + 2048;
    if (b < T5) {
        TDesc d = tile_desc(p, b, tid);
        f32x4 v4[4]; tile_load(d, v4, tid);
        for (int it = b; it < T5; it += nb) {
            const int itn = it + nb;
            TDesc dn = d; f32x4 vn[4];
            if (itn < T5) { dn = tile_desc(p, itn, tid); tile_load(dn, vn, tid); }
            tile_finish(d, v4, tl, tid);
            if (itn < T5) {
                d = dn;
#pragma unroll
                for (int i = 0; i < 4; ++i) v4[i] = vn[i];
            }
        }
    }
}

static DEVI void phase1(const Params& p, int tid) {
    const int lane = tid & 63, gw = blockIdx.x * 4 + __builtin_amdgcn_readfirstlane(tid >> 6), nw = gridDim.x * 4;
    const float* mod = (const float*)(p.ws + WS_MOD);
    bf16_t* h = (bf16_t*)((unsigned char*)p.out + DO_H);
    if (tid == 0) { while (__hip_atomic_load((unsigned*)(p.ws + WS_CNT) + 1, __ATOMIC_ACQUIRE, __HIP_MEMORY_SCOPE_AGENT) < 64u) __builtin_amdgcn_s_sleep(2); }
    __syncthreads();
    f32x4 A[4], B[4];
#pragma unroll
    for (int i = 0; i < 4; ++i) {
        const int c0 = i * 256 + lane * 4;
        const f32x4 g = *(const f32x4*)(p.g_pre_mix + c0), sc = *(const f32x4*)(mod + 1024 + c0);
        A[i] = g * (sc + 1.0f); B[i] = *(const f32x4*)(mod + c0);
    }
    for (int r = gw; r < S; r += 2 * nw) {
        const int r1 = r + nw; const bool has1 = r1 < S;
        f32x4 v[4], u[4]; float ss = 0.f, su = 0.f;
#pragma unroll
        for (int i = 0; i < 4; ++i) { v[i] = *(const f32x4*)(p.x + (size_t)r * D + i * 256 + lane * 4); u[i] = *(const f32x4*)(p.x + (size_t)(has1 ? r1 : r) * D + i * 256 + lane * 4); }
#pragma unroll
        for (int i = 0; i < 4; ++i) { ss += v[i][0] * v[i][0] + v[i][1] * v[i][1] + v[i][2] * v[i][2] + v[i][3] * v[i][3]; su += u[i][0] * u[i][0] + u[i][1] * u[i][1] + u[i][2] * u[i][2] + u[i][3] * u[i][3]; }
        ss = wave_sum(ss); su = wave_sum(su);
        const float rstd = rsqrtf(ss * (1.0f / 1024.0f) + EPS), rstu = rsqrtf(su * (1.0f / 1024.0f) + EPS);
#pragma unroll
        for (int i = 0; i < 4; ++i) {
            const f32x4 y = v[i] * rstd * A[i] + B[i];
            u32x2 w; w.x = pk2(y[0], y[1]); w.y = pk2(y[2], y[3]);
            *(u32x2*)(h + (size_t)r * D + i * 256 + lane * 4) = w;
            if (has1) {
                const f32x4 z = u[i] * rstu * A[i] + B[i];
                u32x2 w1; w1.x = pk2(z[0], z[1]); w1.y = pk2(z[2], z[3]);
                *(u32x2*)(h + (size_t)r1 * D + i * 256 + lane * 4) = w1;
            }
        }
    }
}

static DEVI void phase2(const Params& p, unsigned char* lds, int tid) {
    const int lane = tid & 63, wave = __builtin_amdgcn_readfirstlane(tid >> 6), wr = wave >> 1, wc = wave & 1;
    const int lr = lane & 15, lq = lane >> 4;
    const bf16_t* h = (const bf16_t*)((unsigned char*)p.out + DO_H);
    const bf16_t* wt = (const bf16_t*)((unsigned char*)p.out + DO_WIN);
    bf16_t* P = (bf16_t*)(p.ws + WS_P);
    bf16_t* KI = (bf16_t*)(p.ws + WS_KI);
    float* AUX = (float*)(p.ws + WS_AUX);
    const float2* rope = (const float2*)(p.ws + WS_ROPE);
    bool pre = false;
    for (int i = blockIdx.x; i < 2880; i += gridDim.x) {
        const int xcd = i & 7, j = i >> 3, nt = j >> 3, mt = xcd * 8 + (j & 7);
        const int inx = i + gridDim.x; const bool has_next = inx < 2880;
        const int jn = (has_next ? inx : i) >> 3, ntn = jn >> 3, mtn = xcd * 8 + (jn & 7);
        f32x4 acc[8][4];
#pragma unroll
        for (int m = 0; m < 8; ++m)
#pragma unroll
            for (int n = 0; n < 4; ++n) acc[m][n] = (f32x4){0.f, 0.f, 0.f, 0.f};
        gemm256b(acc, h + (size_t)(mt * 256 + (tid >> 3)) * D + gemm_kc(tid), wt + (size_t)(nt * 128 + (tid >> 3)) * D + gemm_kc(tid), D, D, 16, lds, tid,
                 pre, (mtn - mt) * 256 * D, (ntn - nt) * 128 * D, has_next);
        pre = has_next;
        const int colw = nt * 128 + wc * 64;
        int kind;
        if (nt < 2) kind = 1; else if (nt < 12) kind = 0; else if (nt < 16) kind = 3; else if (nt < 20) kind = 2; else if (nt < 24) kind = 0; else if (nt < 28) kind = 2;
        else if (nt < 44) kind = 4; else kind = (wc == 0) ? 5 : 6;
#pragma unroll
        for (int m = 0; m < 8; ++m) {
            const int row = mt * 256 + wr * 128 + m * 16 + lr;
            f32x4 v[4];
#pragma unroll
            for (int n = 0; n < 4; ++n) v[n] = acc[m][n];
            if (kind == 5) {
                float s = 0.f;
#pragma unroll
                for (int n = 0; n < 4; ++n) s += (v[n][0] + v[n][1]) + (v[n][2] + v[n][3]);
                s += __shfl_xor(s, 16); s += __shfl_xor(s, 32);
                const float mu = s * (1.0f / 64.0f);
                float q = 0.f;
#pragma unroll
                for (int n = 0; n < 4; ++n) { v[n] = v[n] - mu; q += (v[n][0] * v[n][0] + v[n][1] * v[n][1]) + (v[n][2] * v[n][2] + v[n][3] * v[n][3]); }
                q += __shfl_xor(q, 16); q += __shfl_xor(q, 32);
                const float rs = rsqrtf(q * (1.0f / 64.0f) + EPS);
#pragma unroll
                for (int n = 0; n < 4; ++n) v[n] = v[n] * rs * *(const f32x4*)(p.g_idx_k + n * 16 + lq * 4);
            }
            if (kind == 2 || kind == 3 || kind == 5) {
#pragma unroll
                for (int jj = 0; jj < 4; ++jj) {
                    const float self = v[0][jj], other = __shfl_xor(self, 32);
                    const float2 cs = rope[(size_t)row * 8 + ((lq * 4 + jj) & 7)];
                    v[0][jj] = (lq < 2) ? (self * cs.x - other * cs.y) : (other * cs.y + self * cs.x);
                }
            }
            if (kind == 1 || kind == 3) {
#pragma unroll
                for (int n = 0; n < 4; ++n) v[n] = v[n] * 0.125f;
            }
            if (kind == 4) {
#pragma unroll
                for (int n = 0; n < 4; ++n)
#pragma unroll
                    for (int jj = 0; jj < 4; ++jj) v[n][jj] = sigmoidf_(v[n][jj]);
            }
            if (nt >= 16 && nt < 20) {
                const int head = (nt - 16) * 2 + wc;
                float am = 0.f;
#pragma unroll
                for (int n = 0; n < 4; ++n) am = fmaxf(fmaxf(am, fmaxf(fabsf(v[n][0]), fabsf(v[n][1]))), fmaxf(fabsf(v[n][2]), fabsf(v[n][3])));
                am = fmaxf(am, __shfl_xor(am, 16)); am = fmaxf(am, __shfl_xor(am, 32));
                const unsigned skb = pk2(am * (1.0f / 127.0f), 0.f) & 0xffffu;
                const float skf = bflo(skb), inv = skf > 0.f ? 1.0f / skf : 0.f;
                unsigned char* k8 = (unsigned char*)P + (size_t)row * (LDP * 2) + 4096 + head * 128;
#pragma unroll
                for (int n = 0; n < 4; ++n) {
                    int q4[4];
#pragma unroll
                    for (int jj = 0; jj < 4; ++jj) q4[jj] = (int)__builtin_rintf(fminf(fmaxf(v[n][jj] * inv, -127.f), 127.f));
                    const int w8 = (q4[0] & 0xff) | ((q4[1] & 0xff) << 8) | ((q4[2] & 0xff) << 16) | (q4[3] << 24);
                    *(int*)(k8 + (n * 2 + (lq >> 1)) * 16 + (lq & 1) * 4) = w8;
                }
                if (lq == 0) ((unsigned short*)(p.ws + WS_SKT))[head * S + row] = (unsigned short)skb;
            } else if (nt >= 20 && nt < 24) {
                const int isv = 1, head = (nt - 20) * 2 + wc;
                unsigned char* kv8 = (unsigned char*)P + (size_t)row * (LDP * 2) + 4096 + head * 128 + isv * 8;
#pragma unroll
                for (int n = 0; n < 4; ++n) {
                    f32x4 c = v[n] * 8.0f;
#pragma unroll
                    for (int jj = 0; jj < 4; ++jj) c[jj] = fminf(fmaxf(c[jj], -440.f), 440.f);
                    int w8 = __builtin_amdgcn_cvt_pk_fp8_f32(c[0], c[1], 0, false);
                    w8 = __builtin_amdgcn_cvt_pk_fp8_f32(c[2], c[3], w8, true);
                    *(int*)(kv8 + (n * 2 + (lq >> 1)) * 16 + (lq & 1) * 4) = w8;
                }
            } else if (kind == 6) {
                if (lq < 4) *(f32x4*)(AUX + (size_t)row * 32 + lq * 4) = v[0];
                if (lq < 2) *(f32x4*)(AUX + (size_t)row * 32 + 16 + lq * 4) = v[1] * (0.35355339059327379f * 0.125f);
            } else {
#pragma unroll
                for (int n = 0; n < 4; ++n) {
                    u32x2 w; w.x = pk2(v[n][0], v[n][1]); w.y = pk2(v[n][2], v[n][3]);
                    *(u32x2*)(P + (size_t)row * LDP + colw + n * 16 + lq * 4) = w;
                    if (kind == 5) *(u32x2*)(KI + ((size_t)((row >> 5) * 4 + n) * 64 + (lq >> 1) * 32 + (row & 31)) * 8 + (lq & 1) * 4) = w;
                }
            }
        }
    }
}

constexpr int GL_QT = 0, GL_KT = 8192, GL_VT = 16384, GL_ST = 32768, GL_AM = 49152, GL_TOT = 57344;
DEVI int el_off(int row, int col) { return tile_off(row, col >> 3) + (col & 7) * 2; }

template <bool G3>
static DEVI void gla_item(const Params& p, int item, unsigned char* lds, int tid) {
    const int n = item >> 2, h = item & 3, t0 = n * 64;
    const int lane = tid & 63, wave = __builtin_amdgcn_readfirstlane(tid >> 6), lr = lane & 15, lq = lane >> 4;
    bf16_t* P = (bf16_t*)(p.ws + WS_P);
    const float* AUX = (const float*)(p.ws + WS_AUX);
    float* U = (float*)((unsigned char*)p.out + DO_H);
    float* GD = (float*)((unsigned char*)p.out + DO_GD);
    float* TOT = (float*)(lds + GL_TOT);
    __syncthreads();
    {
        const int d = tid & 63, tq = tid >> 6, colh = h * 64 + d;
        float w2r[16];
#pragma unroll
        for (int r = 0; r < 16; ++r) w2r[r] = p.w_gla_a2[r * 256 + colh];
        const float bb = p.b_gla_a[colh];
        float bc[16]; float run = 0.f;
#pragma unroll
        for (int i = 0; i < 16; ++i) {
            const float* ga = AUX + (size_t)(t0 + tq * 16 + i) * 32;
            float z = bb;
#pragma unroll
            for (int r4 = 0; r4 < 4; ++r4) { const f32x4 g = *(const f32x4*)(ga + r4 * 4); z += g[0] * w2r[r4 * 4] + g[1] * w2r[r4 * 4 + 1] + g[2] * w2r[r4 * 4 + 2] + g[3] * w2r[r4 * 4 + 3]; }
            const float ls = fminf(z, 0.f) - __logf(1.0f + __expf(-fabsf(z)));
            run += ls * (1.0f / 16.0f); bc[i] = run;
        }
        TOT[tq * 64 + d] = run;
        __syncthreads();
        float off = 0.f, blast = 0.f;
#pragma unroll
        for (int q = 0; q < 4; ++q) { const float v = TOT[q * 64 + d]; blast += v; off += (q < tq) ? v : 0.f; }
#pragma unroll
        for (int i = 0; i < 16; ++i) {
            const int tl = tq * 16 + i; const size_t rowp = (size_t)(t0 + tl) * LDP;
            const float b = bc[i] + off;
            const float kv = bf2f(P[rowp + C_GK + colh]);
            if (G3) {
                const float qv = bf2f(P[rowp + C_GQ + colh]);
                *(bf16_t*)(lds + GL_QT + el_off(tl, d)) = (bf16_t)f2bf(qv * __expf(b));
                *(bf16_t*)(lds + GL_KT + el_off(tl, d)) = (bf16_t)f2bf(kv * __expf(-b));
            } else {
                *(bf16_t*)(lds + GL_KT + el_off(d, tl)) = (bf16_t)f2bf(kv * __expf(blast - b));
            }
        }
        if (!G3 && tq == 0) GD[(size_t)item * 64 + d] = __expf(blast);
    }
    {
        const int v0 = (tid & 15) * 8;
#pragma unroll
        for (int i = 0; i < 4; ++i) {
            const int s = (tid >> 4) + 16 * i;
            const u32x4 w = *(const u32x4*)(P + (size_t)(t0 + s) * LDP + C_GV + h * 128 + v0);
            const unsigned ww[4] = {w.x, w.y, w.z, w.w};
#pragma unroll
            for (int j = 0; j < 8; ++j) *(bf16_t*)(lds + GL_VT + el_off(v0 + j, s)) = (bf16_t)((ww[j >> 1] >> ((j & 1) * 16)) & 0xffffu);
        }
    }
    if (G3) {
        const int v = tid & 127, dg = tid >> 7;
        const float* Sn = U + (size_t)item * 8192;
#pragma unroll 8
        for (int i = 0; i < 32; ++i) { const int d = dg * 32 + i; *(bf16_t*)(lds + GL_ST + el_off(v, d)) = (bf16_t)f2bf(Sn[d * 128 + v]); }
    }
    __syncthreads();
    if (G3) {
        bf16x8 aq[2];
#pragma unroll
        for (int ks = 0; ks < 2; ++ks) aq[ks] = *(const bf16x8*)(lds + GL_QT + tile_off(wave * 16 + lr, ks * 4 + lq));
        const int tl = wave * 16 + lr;
#pragma unroll
        for (int nb = 0; nb < 4; ++nb) {
            f32x4 c = {0.f, 0.f, 0.f, 0.f};
#pragma unroll
            for (int ks = 0; ks < 2; ++ks) { const bf16x8 bk = *(const bf16x8*)(lds + GL_KT + tile_off(nb * 16 + lr, ks * 4 + lq)); c = __builtin_amdgcn_mfma_f32_16x16x32_bf16(bk, aq[ks], c, 0, 0, 0); }
#pragma unroll
            for (int j = 0; j < 4; ++j) c[j] = (nb * 16 + 4 * lq + j <= tl) ? c[j] : 0.f;
            u32x2 w; w.x = pk2(c[0], c[1]); w.y = pk2(c[2], c[3]);
            *(u32x2*)(lds + GL_AM + tile_off(tl, nb * 2 + (lq >> 1)) + (lq & 1) * 8) = w;
        }
        __syncthreads();
        bf16x8 am[2];
#pragma unroll
        for (int ks = 0; ks < 2; ++ks) am[ks] = *(const bf16x8*)(lds + GL_AM + tile_off(tl, ks * 4 + lq));
        f32x4 o[8]; float ss = 0.f;
#pragma unroll
        for (int vb = 0; vb < 8; ++vb) {
            f32x4 c = {0.f, 0.f, 0.f, 0.f};
#pragma unroll
            for (int ks = 0; ks < 2; ++ks) {
                const bf16x8 bs = *(const bf16x8*)(lds + GL_ST + tile_off(vb * 16 + lr, ks * 4 + lq));
                c = __builtin_amdgcn_mfma_f32_16x16x32_bf16(bs, aq[ks], c, 0, 0, 0);
                const bf16x8 bv = *(const bf16x8*)(lds + GL_VT + tile_off(vb * 16 + lr, ks * 4 + lq));
                c = __builtin_amdgcn_mfma_f32_16x16x32_bf16(bv, am[ks], c, 0, 0, 0);
            }
            o[vb] = c; ss += (c[0] * c[0] + c[1] * c[1]) + (c[2] * c[2] + c[3] * c[3]);
        }
        ss += __shfl_xor(ss, 16); ss += __shfl_xor(ss, 32);
        const float rstd = rsqrtf(ss * (1.0f / 128.0f) + EPS);
        const size_t rowp = (size_t)(t0 + tl) * LDP;
#pragma unroll
        for (int vb = 0; vb < 8; ++vb) {
            const int v0 = vb * 16 + 4 * lq;
            const u32x2 gg = *(const u32x2*)(P + rowp + C_GG + h * 128 + v0);
            const f32x4 g4 = *(const f32x4*)(p.g_gla_out + v0);
            const float y0 = o[vb][0] * rstd * g4[0] * siluf_(bflo(gg.x)), y1 = o[vb][1] * rstd * g4[1] * siluf_(bfhi(gg.x));
            const float y2 = o[vb][2] * rstd * g4[2] * siluf_(bflo(gg.y)), y3 = o[vb][3] * rstd * g4[3] * siluf_(bfhi(gg.y));
            u32x2 w; w.x = pk2(y0, y1); w.y = pk2(y2, y3);
            *(u32x2*)(P + rowp + C_OA + h * 128 + v0) = w;
        }
    } else {
        bf16x8 ak[2];
#pragma unroll
        for (int ks = 0; ks < 2; ++ks) ak[ks] = *(const bf16x8*)(lds + GL_KT + tile_off(wave * 16 + lr, ks * 4 + lq));
#pragma unroll
        for (int vb = 0; vb < 8; ++vb) {
            f32x4 c = {0.f, 0.f, 0.f, 0.f};
#pragma unroll
            for (int ks = 0; ks < 2; ++ks) { const bf16x8 bv = *(const bf16x8*)(lds + GL_VT + tile_off(vb * 16 + lr, ks * 4 + lq)); c = __builtin_amdgcn_mfma_f32_16x16x32_bf16(bv, ak[ks], c, 0, 0, 0); }
            *(f32x4*)(U + (size_t)item * 8192 + (wave * 16 + lr) * 128 + vb * 16 + 4 * lq) = c;
        }
    }
}

static DEVI void gla_scan(const Params& p, int tid) {
    float* U = (float*)((unsigned char*)p.out + DO_H);
    const float* GD = (const float*)((unsigned char*)p.out + DO_GD);
    for (int e = blockIdx.x * NT + tid; e < 32768; e += gridDim.x * NT) {
        const int hd = e >> 7;
        float st = 0.f;
        float u[32], g[32];
#pragma unroll
        for (int q = 0; q < 32; ++q) { u[q] = U[(size_t)q * 32768 + e]; g[q] = GD[(size_t)q * 256 + hd]; }
        for (int n0 = 0; n0 < 256; n0 += 32) {
            float un[32], gn[32];
            const int n1 = n0 + 32 < 256 ? n0 + 32 : n0;
#pragma unroll
            for (int q = 0; q < 32; ++q) { un[q] = U[(size_t)(n1 + q) * 32768 + e]; gn[q] = GD[(size_t)(n1 + q) * 256 + hd]; }
#pragma unroll
            for (int q = 0; q < 32; ++q) { U[(size_t)(n0 + q) * 32768 + e] = st; st = g[q] * st + u[q]; }
#pragma unroll
            for (int q = 0; q < 32; ++q) { u[q] = un[q]; g[q] = gn[q]; }
        }
    }
}

constexpr int TK_CAP = 512, TK_K = 256, TK_WBYTES = 16384;
DEVI unsigned fkey(float f) { const unsigned b = __float_as_uint(f); return b ^ ((unsigned)((int)b >> 31) | 0x80000000u); }
DEVI int lane_prefix(unsigned long long m) { return __builtin_amdgcn_mbcnt_hi((unsigned)(m >> 32), __builtin_amdgcn_mbcnt_lo((unsigned)m, 0)); }

DEVI unsigned topk_prune(unsigned* s, int n, unsigned lo, int slack, int lane, int& cnew) {
    unsigned u[8]; unsigned mx = 0u;
#pragma unroll
    for (int i = 0; i < 8; ++i) { const int pos = i * 64 + lane; const unsigned v = s[pos]; u[i] = (pos < n) ? v : 0u; mx = u[i] > mx ? u[i] : mx; }
    mx = __ockl_wfred_max_u32(mx);
    const int top = 31 - __builtin_clz(mx ^ lo);
    unsigned T = (top >= 31) ? 0u : (mx & ~((2u << top) - 1u));
    int cT = n;
    for (int bit = top; bit >= 0; --bit) {
        const unsigned trial = T | (1u << bit);
        unsigned long long bm[8];
#pragma unroll
        for (int i = 0; i < 8; ++i) bm[i] = __ballot(u[i] >= trial);
        int c = 0;
#pragma unroll
        for (int i = 0; i < 8; ++i) c += __builtin_popcountll(bm[i]);
        if (c >= TK_K) { T = trial; cT = c; if (c <= TK_K + slack) break; }
    }
    int nb = 0;
#pragma unroll
    for (int i = 0; i < 8; ++i) {
        const bool keep = u[i] >= T;
        const unsigned long long km = __ballot(keep);
        if (keep) s[nb + lane_prefix(km)] = u[i];
        nb += __builtin_popcountll(km);
    }
    cnew = cT;
    return T;
}

static DEVI void topk_phase(const Params& p, unsigned char* lds, int tid) {
    const int lane = tid & 63, wave = __builtin_amdgcn_readfirstlane(tid >> 6), gw = blockIdx.x * 4 + wave, nw = gridDim.x * 4;
    const int r = lane & 31, hh = lane >> 5;
    const bf16_t* P = (const bf16_t*)(p.ws + WS_P);
    const bf16_t* KI = (const bf16_t*)(p.ws + WS_KI);
    const float* AUX = (const float*)(p.ws + WS_AUX);
    unsigned short* SEL = (unsigned short*)(p.ws + WS_SEL);
    int* SELC = (int*)(p.ws + WS_SELC);
    unsigned* cb = (unsigned*)(lds + wave * TK_WBYTES);
    for (int item = gw; item < 2048; item += nw) {
        const int qb0 = 4 * item, qb1 = 4 * (4095 - item);
        bf16x8 a[2][4]; u32x4 wf[2][2];
#pragma unroll
        for (int rt = 0; rt < 2; ++rt) {
            const int qb = rt ? qb1 : qb0;
            const int qa = qb + ((r >> 2) & 1) + 2 * ((r >> 4) & 1), ha = (r & 3) + 4 * ((r >> 3) & 1);
#pragma unroll
            for (int s4 = 0; s4 < 4; ++s4) a[rt][s4] = *(const bf16x8*)(P + (size_t)qa * LDP + C_IQ + ha * 64 + 16 * s4 + 8 * hh);
#pragma unroll
            for (int s = 0; s < 2; ++s) {
                const f32x4 w0 = *(const f32x4*)(AUX + (size_t)(qb + hh + 2 * s) * 32 + 16), w1 = *(const f32x4*)(AUX + (size_t)(qb + hh + 2 * s) * 32 + 20);
                const bool mine = (r == 4 * hh + s);
                u32x4 f; f.x = pk2(w0[0], w0[1]); f.y = pk2(w0[2], w0[3]); f.z = pk2(w1[0], w1[1]); f.w = pk2(w1[2], w1[3]);
                wf[rt][s] = mine ? f : (u32x4){0u, 0u, 0u, 0u};
            }
        }
        int cnt[8]; unsigned thr[8];
#pragma unroll
        for (int q = 0; q < 8; ++q) { cnt[q] = 0; thr[q] = 0u; }
        const int ntile0 = (qb0 + 3) / 32 + 1, ntile = (qb1 + 3) / 32 + 1;
        const unsigned char* KIb = (const unsigned char*)KI;
        auto loadb = [&](bf16x8 (&b)[4], int kt) {
            const int kc = kt < ntile ? kt : ntile - 1;
            const unsigned off = (unsigned)kc * 4096u + (unsigned)lane * 16u;
#pragma unroll
            for (int s4 = 0; s4 < 4; ++s4) b[s4] = *(const bf16x8*)(KIb + (off + s4 * 1024u));
        };
        unsigned thv[2][2];
        auto refresh_thv = [&]() {
#pragma unroll
            for (int rt = 0; rt < 2; ++rt)
#pragma unroll
                for (int sel = 0; sel < 2; ++sel) thv[rt][sel] = hh ? thr[rt * 4 + 2 * sel + 1] : thr[rt * 4 + 2 * sel];
        };
        int cmax = 0;
        auto prune_while = [&](int limit, int slack) {
            if (cmax <= limit) return;
            for (;;) {
                int qi = -1;
#pragma unroll
                for (int q = 7; q >= 0; --q) qi = (cnt[q] > limit) ? q : qi;
                qi = __builtin_amdgcn_readfirstlane(qi);
                if (qi < 0) {
                    refresh_thv();
                    cmax = 0;
#pragma unroll
                    for (int q = 0; q < 8; ++q) cmax = cnt[q] > cmax ? cnt[q] : cmax;
                    break;
                }
                int nq = 0; unsigned lo = 0u;
#pragma unroll
                for (int q = 0; q < 8; ++q) { nq = (q == qi) ? cnt[q] : nq; lo = (q == qi) ? thr[q] : lo; }
                int cn;
                const unsigned T = topk_prune(cb + qi * TK_CAP, nq, lo, slack, lane, cn);
#pragma unroll
                for (int q = 0; q < 8; ++q) if (q == qi) { cnt[q] = __builtin_amdgcn_readfirstlane(cn); thr[q] = __builtin_amdgcn_readfirstlane(T); }
            }
        };
        refresh_thv();
        auto score_tile = [&](const f32x16& acc, int rt, int kt, bool masked) {
            const int key = kt * 32 + r, qb = rt ? qb1 : qb0;
            u32x4 x0, x1;
            x0.x = relu2_bf16(pk2(acc[0], acc[1])); x0.y = relu2_bf16(pk2(acc[2], acc[3])); x0.z = relu2_bf16(pk2(acc[4], acc[5])); x0.w = relu2_bf16(pk2(acc[6], acc[7]));
            x1.x = relu2_bf16(pk2(acc[8], acc[9])); x1.y = relu2_bf16(pk2(acc[10], acc[11])); x1.z = relu2_bf16(pk2(acc[12], acc[13])); x1.w = relu2_bf16(pk2(acc[14], acc[15]));
            f32x16 y;
#pragma unroll
            for (int q = 0; q < 16; ++q) y[q] = 0.f;
            y = __builtin_amdgcn_mfma_f32_32x32x16_bf16(__builtin_bit_cast(bf16x8, wf[rt][0]), __builtin_bit_cast(bf16x8, x0), y, 0, 0, 0);
            y = __builtin_amdgcn_mfma_f32_32x32x16_bf16(__builtin_bit_cast(bf16x8, wf[rt][1]), __builtin_bit_cast(bf16x8, x1), y, 0, 0, 0);
#pragma unroll
            for (int sel = 0; sel < 2; ++sel) {
                const float s = sel ? y[1] : y[0];
                const int ql = rt * 4 + 2 * sel, qh = ql + 1;
                const unsigned comp = (fkey(s) & 0xFFFFC000u) | (unsigned)(16383 - key);
                bool pass = comp > thv[rt][sel];
                if (masked) pass = pass && (key <= qb + 2 * sel + hh);
                const unsigned long long m = __ballot(pass);
                if (m) {
                    const unsigned lo = (unsigned)m, hi = (unsigned)(m >> 32);
                    const int nlo = __builtin_popcount(lo), nhi = __builtin_popcount(hi);
                    const int basev = hh ? (cnt[qh] - nlo) : cnt[ql];
                    const int pos = __builtin_amdgcn_mbcnt_hi(hi, __builtin_amdgcn_mbcnt_lo(lo, basev));
                    if (pass) cb[(ql + hh) * TK_CAP + pos] = comp;
                    cnt[ql] = __builtin_amdgcn_readfirstlane(cnt[ql] + nlo); cnt[qh] = __builtin_amdgcn_readfirstlane(cnt[qh] + nhi);
                    cmax = cnt[ql] > cmax ? cnt[ql] : cmax; cmax = cnt[qh] > cmax ? cnt[qh] : cmax;
                }
            }
        };
        auto step = [&](bf16x8 (&b)[4], int kt) {
            if (kt < ntile) {
                f32x16 acc1;
#pragma unroll
                for (int q = 0; q < 16; ++q) acc1[q] = 0.f;
#pragma unroll
                for (int s4 = 0; s4 < 4; ++s4) acc1 = __builtin_amdgcn_mfma_f32_32x32x16_bf16(a[1][s4], b[s4], acc1, 0, 0, 0);
                if (kt < ntile0) {
                    f32x16 acc0;
#pragma unroll
                    for (int q = 0; q < 16; ++q) acc0[q] = 0.f;
#pragma unroll
                    for (int s4 = 0; s4 < 4; ++s4) acc0 = __builtin_amdgcn_mfma_f32_32x32x16_bf16(a[0][s4], b[s4], acc0, 0, 0, 0);
                    if (kt == ntile0 - 1) score_tile(acc0, 0, kt, true); else score_tile(acc0, 0, kt, false);
                }
                if (kt == ntile - 1) score_tile(acc1, 1, kt, true); else score_tile(acc1, 1, kt, false);
                prune_while(TK_CAP - 32, 32);
            }
            loadb(b, kt + 6);
        };
        bf16x8 b0[4], b1[4], b2[4], b3[4], b4[4], b5[4];
        loadb(b0, 0); loadb(b1, 1); loadb(b2, 2); loadb(b3, 3); loadb(b4, 4); loadb(b5, 5);
        for (int kt = 0; kt < ntile; kt += 6) { step(b0, kt); step(b1, kt + 1); step(b2, kt + 2); step(b3, kt + 3); step(b4, kt + 4); step(b5, kt + 5); }
        cmax = TK_CAP; prune_while(TK_K, 0);
#pragma unroll
        for (int qi = 0; qi < 8; ++qi) {
            const int c = cnt[qi], qg = ((qi >> 2) ? qb1 : qb0) + (qi & 3);
#pragma unroll
            for (int i = 0; i < 4; ++i) { const int pos = i * 64 + lane; const unsigned v = cb[qi * TK_CAP + pos]; SEL[(size_t)qg * 256 + pos] = (pos < c) ? (unsigned short)(16383u - (v & 0x3FFFu)) : (unsigned short)0; }
            if (lane == 0) SELC[qg] = c;
        }
    }
}

typedef float f32x2d_t __attribute__((ext_vector_type(2)));
DEVI float dpp_f(float x, const int ctrl_sel) {
    const int xi = __builtin_bit_cast(int, x);
    const int y = (ctrl_sel == 0) ? __builtin_amdgcn_update_dpp(0, xi, 0xB1, 0xF, 0xF, true) : (ctrl_sel == 1) ? __builtin_amdgcn_update_dpp(0, xi, 0x4E, 0xF, 0xF, true)
                                                                                                              : __builtin_amdgcn_update_dpp(0, xi, 0x141, 0xF, 0xF, true);
    return __builtin_bit_cast(float, y);
}
DEVI float red8_max(float v) { v = fmaxf(v, dpp_f(v, 0)); v = fmaxf(v, dpp_f(v, 1)); v = fmaxf(v, dpp_f(v, 2)); return v; }
DEVI float red8_sum(float v) { v += dpp_f(v, 0); v += dpp_f(v, 1); v += dpp_f(v, 2); return v; }
DEVI int dpp_i(int x, const int ctrl_sel) {
    return (ctrl_sel == 0) ? __builtin_amdgcn_update_dpp(0, x, 0xB1, 0xF, 0xF, true) : (ctrl_sel == 1) ? __builtin_amdgcn_update_dpp(0, x, 0x4E, 0xF, 0xF, true) : __builtin_amdgcn_update_dpp(0, x, 0x141, 0xF, 0xF, true);
}
DEVI int xreduce8i(const int (&part)[8], int lane) {
    int r4[4], r2[2];
#pragma unroll
    for (int j = 0; j < 4; ++j) { const int mine = (lane & 4) ? part[j + 4] : part[j], send = (lane & 4) ? part[j] : part[j + 4]; r4[j] = mine + dpp_i(send, 2); }
#pragma unroll
    for (int j = 0; j < 2; ++j) { const int mine = (lane & 2) ? r4[j + 2] : r4[j], send = (lane & 2) ? r4[j] : r4[j + 2]; r2[j] = mine + dpp_i(send, 1); }
    const int mine = (lane & 1) ? r2[1] : r2[0], send = (lane & 1) ? r2[0] : r2[1];
    return mine + dpp_i(send, 0);
}
DEVI float xreduce8(const float (&part)[8], int lane) {
    float r4[4], r2[2];
#pragma unroll
    for (int j = 0; j < 4; ++j) { const float mine = (lane & 4) ? part[j + 4] : part[j], send = (lane & 4) ? part[j] : part[j + 4]; r4[j] = mine + dpp_f(send, 2); }
#pragma unroll
    for (int j = 0; j < 2; ++j) { const float mine = (lane & 2) ? r4[j + 2] : r4[j], send = (lane & 2) ? r4[j] : r4[j + 2]; r2[j] = mine + dpp_f(send, 1); }
    const float mine = (lane & 1) ? r2[1] : r2[0], send = (lane & 1) ? r2[0] : r2[1];
    return mine + dpp_f(send, 0);
}
template <bool LT>
static DEVI void sa_item(const Params& p, unsigned char* wl, const unsigned short* skl, int grp, int h, int lane) {
    const unsigned char* Pb = (const unsigned char*)(p.ws + WS_P);
    const unsigned short* SEL = (const unsigned short*)(p.ws + WS_SEL);
    const int* SELC = (const int*)(p.ws + WS_SELC);
    unsigned short* sI = (unsigned short*)wl;
    float* sP = (float*)(wl + 4096);
    const int qi = lane >> 3, d8 = lane & 7, t0 = grp * 8, t = t0 + qi;
    const int n = SELC[t], nlast = __builtin_amdgcn_readfirstlane(SELC[t0 + 7]);
    const int ng = (nlast + 7) >> 3;
#pragma unroll
    for (int i = 0; i < 4; ++i) *(u32x4*)(wl + i * 1024 + lane * 16) = *(const u32x4*)((const unsigned char*)(SEL + (size_t)t0 * 256) + i * 1024 + lane * 16);
    asm volatile("" ::: "memory");
    const u32x4 qv = *(const u32x4*)(Pb + (unsigned)t * (LDP * 2) + (C_DQ + h * 64 + d8 * 8) * 2);
    const float qf[8] = {bflo(qv.x), bfhi(qv.x), bflo(qv.y), bfhi(qv.y), bflo(qv.z), bfhi(qv.z), bflo(qv.w), bfhi(qv.w)};
    float qa = 0.f;
#pragma unroll
    for (int i = 0; i < 8; ++i) qa = fmaxf(qa, fabsf(qf[i]));
    qa = red8_max(qa);
    const float qinv = qa > 0.f ? 127.0f / qa : 0.f, qs = qa * (1.4426950408889634f / 127.0f);
    int qq[8];
#pragma unroll
    for (int i = 0; i < 8; ++i) qq[i] = (int)__builtin_rintf(qf[i] * qinv);
    const int q8a = (qq[0] & 0xff) | ((qq[1] & 0xff) << 8) | ((qq[2] & 0xff) << 16) | (qq[3] << 24), q8b = (qq[4] & 0xff) | ((qq[5] & 0xff) << 8) | ((qq[6] & 0xff) << 16) | (qq[7] << 24);
    const unsigned short* skg = (const unsigned short*)(p.ws + WS_SKT) + (size_t)h * S;
    const unsigned kvoff = 4096u + h * 128 + d8 * 16;
    float m = -__builtin_inff(), lsum = 0.f;
    f32x2d_t acc2[4] = {{0.f, 0.f}, {0.f, 0.f}, {0.f, 0.f}, {0.f, 0.f}};
    auto compute2 = [&](const u32x4 (&kv)[16], const unsigned (&sk)[2], int g) {
        int part[2][8];
#pragma unroll
        for (int j = 0; j < 16; ++j) part[j >> 3][j & 7] = __builtin_amdgcn_sdot4(q8b, (int)kv[j].y, __builtin_amdgcn_sdot4(q8a, (int)kv[j].x, 0, false), false);
        float s0 = (float)xreduce8i(part[0], lane) * (qs * bflo(sk[0])), s1 = (float)xreduce8i(part[1], lane) * (qs * bflo(sk[1]));
        s0 = (g * 8 + d8 < n) ? s0 : -__builtin_inff();
        s1 = (g * 8 + 8 + d8 < n) ? s1 : -__builtin_inff();
        const float mnew = fmaxf(m, red8_max(fmaxf(s0, s1)));
        const float sc = __builtin_amdgcn_exp2f(m - mnew), pm0 = __builtin_amdgcn_exp2f(s0 - mnew), pm1 = __builtin_amdgcn_exp2f(s1 - mnew);
        lsum = lsum * sc + red8_sum(pm0 + pm1);
        m = mnew;
        asm volatile("" ::: "memory");
        sP[lane] = pm0; sP[64 + lane] = pm1;
        asm volatile("" ::: "memory");
        const f32x4 p0 = *(const f32x4*)(sP + qi * 8), p1 = *(const f32x4*)(sP + qi * 8 + 4), p2 = *(const f32x4*)(sP + 64 + qi * 8), p3 = *(const f32x4*)(sP + 64 + qi * 8 + 4);
        asm volatile("" ::: "memory");
        const f32x2d_t sc2 = {sc, sc};
#pragma unroll
        for (int i = 0; i < 4; ++i) acc2[i] = acc2[i] * sc2;
#pragma unroll
        for (int j = 0; j < 16; ++j) {
            const float pj = (j < 4) ? p0[j & 3] : (j < 8) ? p1[j & 3] : (j < 12) ? p2[j & 3] : p3[j & 3];
            const f32x2d_t pj2 = {pj, pj};
            const int v0 = (int)kv[j].z, v1 = (int)kv[j].w;
            acc2[0] = pj2 * __builtin_amdgcn_cvt_pk_f32_fp8(v0, false) + acc2[0];
            acc2[1] = pj2 * __builtin_amdgcn_cvt_pk_f32_fp8(v0, true) + acc2[1];
            acc2[2] = pj2 * __builtin_amdgcn_cvt_pk_f32_fp8(v1, false) + acc2[2];
            acc2[3] = pj2 * __builtin_amdgcn_cvt_pk_f32_fp8(v1, true) + acc2[3];
        }
    };
    auto issue2 = [&](u32x4 (&dst)[16], unsigned (&sk)[2], int g) {
        const int ga = g < 31 ? g : 30;
        const unsigned ia = sI[qi * 256 + ga * 8 + d8], ib = sI[qi * 256 + ga * 8 + 8 + d8];
        sk[0] = LT ? skl[ia] : skg[ia]; sk[1] = LT ? skl[ib] : skg[ib];
        const u32x4 iw = *(const u32x4*)(sI + qi * 256 + ga * 8), ix = *(const u32x4*)(sI + qi * 256 + ga * 8 + 8);
        const unsigned id[16] = {iw.x & 0xffffu, iw.x >> 16, iw.y & 0xffffu, iw.y >> 16, iw.z & 0xffffu, iw.z >> 16, iw.w & 0xffffu, iw.w >> 16,
                                 ix.x & 0xffffu, ix.x >> 16, ix.y & 0xffffu, ix.y >> 16, ix.z & 0xffffu, ix.z >> 16, ix.w & 0xffffu, ix.w >> 16};
#pragma unroll
        for (int j = 0; j < 16; ++j) dst[j] = *(const u32x4*)(Pb + (id[j] * (unsigned)(LDP * 2) + kvoff));
    };
    u32x4 kvX[16], kvY[16]; unsigned skX[2], skY[2];
    issue2(kvX, skX, 0); issue2(kvY, skY, 2 < ng ? 2 : 0);
    for (int g = 0; g < ng; g += 4) {
        compute2(kvX, skX, g);
        issue2(kvX, skX, g + 4 < ng ? g + 4 : 0);
        if (g + 2 < ng) compute2(kvY, skY, g + 2);
        issue2(kvY, skY, g + 6 < ng ? g + 6 : 0);
    }
    const float inv = 0.125f / lsum;
    u32x4 w; w.x = pk2(acc2[0].x * inv, acc2[0].y * inv); w.y = pk2(acc2[1].x * inv, acc2[1].y * inv); w.z = pk2(acc2[2].x * inv, acc2[2].y * inv); w.w = pk2(acc2[3].x * inv, acc2[3].y * inv);
    *(u32x4*)(p.ws + WS_P + ((size_t)t * LDP + C_OB + h * 64 + d8 * 8) * 2) = w;
    asm volatile("" ::: "memory");
}
static DEVI void sa_phase(const Params& p, unsigned char* lds, int tid) {
    const int lane = tid & 63, wave = __builtin_amdgcn_readfirstlane(tid >> 6);
    unsigned char* wl = lds + wave * 4608;
    if ((gridDim.x & 7) == 0) {
        const int h = blockIdx.x & 7, lw = (blockIdx.x >> 3) * 4 + wave, nlw = (gridDim.x >> 3) * 4;
        unsigned short* skl = (unsigned short*)(lds + 20480);
        const unsigned char* skg = p.ws + WS_SKT + (size_t)h * S * 2;
#pragma unroll
        for (int i = 0; i < 8; ++i) *(u32x4*)((unsigned char*)skl + i * 4096 + tid * 16) = *(const u32x4*)(skg + i * 4096 + tid * 16);
        __syncthreads();
        for (int grp = lw; grp < S / 8; grp += nlw) sa_item<true>(p, wl, skl, grp, h, lane);
    } else {
        const int gw = blockIdx.x * 4 + wave, nw = gridDim.x * 4;
        for (int it = gw; it < S; it += nw) sa_item<false>(p, wl, nullptr, it >> 3, it & 7, lane);
    }
}

template <bool WITH_DSA>
static DEVI void phaseM1(const Params& p, unsigned char* lds, int tid) {
    const int lane = tid & 63, wave = __builtin_amdgcn_readfirstlane(tid >> 6), wr = wave >> 1, wc = wave & 1, lr = lane & 15, lq = lane >> 4;
    const bf16_t* P = (const bf16_t*)(p.ws + WS_P);
    const bf16_t* wpg = (const bf16_t*)((unsigned char*)p.out + DO_WPG);
    const bf16_t* wpd = (const bf16_t*)((unsigned char*)p.out + DO_WPD);
    bf16_t* mix = (bf16_t*)((unsigned char*)p.out + DO_H);
    for (int i = blockIdx.x; i < 1024; i += gridDim.x) {
        const int xcd = i & 7, j = i >> 3, nt = j & 7, mt = xcd * 16 + (j >> 3);
        f32x4 acc[4][4]; zero_acc(acc);
        {
            const bf16_t* ap[4]; const bf16_t* bp[4];
#pragma unroll
            for (int q = 0; q < 4; ++q) {
                ap[q] = P + (size_t)(mt * 128 + q * 32 + (tid >> 3)) * LDP + C_OA + gemm_kc(tid);
                bp[q] = wpg + (size_t)(nt * 128 + q * 32 + (tid >> 3)) * 512 + gemm_kc(tid);
            }
            gemm128(acc, ap, bp, 8, lds, tid);
        }
#pragma unroll
        for (int m = 0; m < 4; ++m) {
            const size_t rowp = (size_t)(mt * 128 + wr * 64 + m * 16 + lr) * LDP;
#pragma unroll
            for (int n = 0; n < 4; ++n) {
                const u32x2 g = *(const u32x2*)(P + rowp + C_BG + nt * 128 + wc * 64 + n * 16 + lq * 4);
                acc[m][n][0] *= bflo(g.x); acc[m][n][1] *= bfhi(g.x); acc[m][n][2] *= bflo(g.y); acc[m][n][3] *= bfhi(g.y);
            }
        }
        if (WITH_DSA) {
            u32x2 park[4][4];
#pragma unroll
            for (int m = 0; m < 4; ++m)
#pragma unroll
                for (int n = 0; n < 4; ++n) { park[m][n].x = pk2(acc[m][n][0], acc[m][n][1]); park[m][n].y = pk2(acc[m][n][2], acc[m][n][3]); }
            zero_acc(acc);
            {
                const bf16_t* ap2[4]; const bf16_t* bp2[4];
#pragma unroll
                for (int q = 0; q < 4; ++q) {
                    ap2[q] = P + (size_t)(mt * 128 + q * 32 + (tid >> 3)) * LDP + C_OB + gemm_kc(tid);
                    bp2[q] = wpd + (size_t)(nt * 128 + q * 32 + (tid >> 3)) * 512 + gemm_kc(tid);
                }
                gemm128(acc, ap2, bp2, 8, lds, tid);
            }
#pragma unroll
            for (int m = 0; m < 4; ++m) {
                const size_t row = (size_t)(mt * 128 + wr * 64 + m * 16 + lr);
#pragma unroll
                for (int n = 0; n < 4; ++n) {
                    const u32x2 g = *(const u32x2*)(P + row * LDP + C_BG + 1024 + nt * 128 + wc * 64 + n * 16 + lq * 4);
                    const u32x2 k = park[m][n];
                    acc[m][n][0] = acc[m][n][0] * bflo(g.x) + bflo(k.x); acc[m][n][1] = acc[m][n][1] * bfhi(g.x) + bfhi(k.x);
                    acc[m][n][2] = acc[m][n][2] * bflo(g.y) + bflo(k.y); acc[m][n][3] = acc[m][n][3] * bfhi(g.y) + bfhi(k.y);
                }
            }
        }
#pragma unroll
        for (int m = 0; m < 4; ++m) {
            const size_t row = (size_t)(mt * 128 + wr * 64 + m * 16 + lr);
#pragma unroll
            for (int n = 0; n < 4; ++n) {
                u32x2 w; w.x = pk2(acc[m][n][0], acc[m][n][1]); w.y = pk2(acc[m][n][2], acc[m][n][3]);
                *(u32x2*)(mix + row * 1024 + nt * 128 + wc * 64 + n * 16 + lq * 4) = w;
            }
        }
    }
}

static DEVI void phaseM2(const Params& p, unsigned char* lds, int tid) {
    const int lane = tid & 63, wave = __builtin_amdgcn_readfirstlane(tid >> 6), wr = wave >> 1, wc = wave & 1, lr = lane & 15, lq = lane >> 4;
    bf16_t* P = (bf16_t*)(p.ws + WS_P);
    const bf16_t* wo = (const bf16_t*)((unsigned char*)p.out + DO_WOUT);
    const bf16_t* mix = (const bf16_t*)((unsigned char*)p.out + DO_H);
    for (int i = blockIdx.x; i < 1024; i += gridDim.x) {
        const int xcd = i & 7, j = i >> 3, nt = j & 7, mt = xcd * 16 + (j >> 3);
        const bf16_t* ap[4]; const bf16_t* bp[4];
#pragma unroll
        for (int q = 0; q < 4; ++q) {
            ap[q] = mix + (size_t)(mt * 128 + q * 32 + (tid >> 3)) * 1024 + gemm_kc(tid);
            bp[q] = wo + (size_t)(nt * 128 + q * 32 + (tid >> 3)) * 1024 + gemm_kc(tid);
        }
        f32x4 acc[4][4]; zero_acc(acc);
        gemm128(acc, ap, bp, 16, lds, tid);
#pragma unroll
        for (int m = 0; m < 4; ++m) {
            bf16_t* orow = P + (size_t)(mt * 128 + wr * 64 + m * 16 + lr) * LDP;
#pragma unroll
            for (int n = 0; n < 4; ++n) { u32x2 w; w.x = pk2(acc[m][n][0], acc[m][n][1]); w.y = pk2(acc[m][n][2], acc[m][n][3]); *(u32x2*)(orow + nt * 128 + wc * 64 + n * 16 + lq * 4) = w; }
        }
    }
}

static DEVI void phaseM3(const Params& p, unsigned char* lds, int tid) {
    const int lane = tid & 63, wave = __builtin_amdgcn_readfirstlane(tid >> 6);
    const float* mod = (const float*)(p.ws + WS_MOD);
    const bf16_t* WrTb = (const bf16_t*)(p.ws + WS_WRT);
    bf16_t* P = (bf16_t*)(p.ws + WS_P);
    int* LIST = (int*)(p.ws + WS_LIST);
    float* CW = (float*)(p.ws + WS_CW);
    int* cnt = (int*)(p.ws + WS_CNT);
    unsigned char* HT = lds;
    float* PART = (float*)(lds + 32768);
    float* LG = (float*)(lds + 32768 + 9216);
    float* BIAS = LG + 16 * 48;
    float* A2S = BIAS + 64;
    float* B2S = A2S + 1024;
    if (tid < 36) BIAS[tid] = tid < 4 ? p.b_rg[tid] : p.b_re[tid - 4];
    *(f32x4*)(A2S + tid * 4) = *(const f32x4*)(p.g_pre_ffn + tid * 4) * (*(const f32x4*)(mod + 4096 + tid * 4) + 1.0f);
    *(f32x4*)(B2S + tid * 4) = *(const f32x4*)(mod + 3072 + tid * 4);
    const int lr = lane & 15, lq = lane >> 4;
    bf16x8 wf[8][3];
#pragma unroll
    for (int s = 0; s < 8; ++s)
#pragma unroll
        for (int c = 0; c < 3; ++c) wf[s][c] = *(const bf16x8*)(WrTb + (size_t)(c * 16 + lr) * 1024 + wave * 256 + s * 32 + lq * 8);
    f32x4 G1[4];
#pragma unroll
    for (int i = 0; i < 4; ++i) {
        const int c0 = i * 256 + lane * 4;
        G1[i] = *(const f32x4*)(mod + 2048 + c0) * *(const f32x4*)(p.g_post_mix + c0);
    }
    for (int it = blockIdx.x; it < S / 16; it += gridDim.x) {
        __syncthreads();
#pragma unroll 1
        for (int rp = 0; rp < 2; ++rp) {
            u32x2 ob[2][4]; f32x4 xv[2][4]; float ss[2] = {0.f, 0.f};
#pragma unroll
            for (int q = 0; q < 2; ++q) {
                const size_t r = (size_t)it * 16 + wave * 4 + rp * 2 + q;
                const bf16_t* orow = P + r * LDP;
#pragma unroll
                for (int i = 0; i < 4; ++i) {
                    ob[q][i] = *(const u32x2*)(orow + i * 256 + lane * 4);
                    xv[q][i] = *(const f32x4*)(p.x + r * D + i * 256 + lane * 4);
                }
            }
#pragma unroll
            for (int q = 0; q < 2; ++q) {
#pragma unroll
                for (int i = 0; i < 4; ++i) { const float o0 = bflo(ob[q][i].x), o1 = bfhi(ob[q][i].x), o2 = bflo(ob[q][i].y), o3 = bfhi(ob[q][i].y); ss[q] += (o0 * o0 + o1 * o1) + (o2 * o2 + o3 * o3); }
                ss[q] = wave_sum(ss[q]);
            }
#pragma unroll
            for (int q = 0; q < 2; ++q) {
                const int rloc = wave * 4 + rp * 2 + q; const size_t r = (size_t)it * 16 + rloc;
                const float rstd1 = rsqrtf(ss[q] * (1.0f / 1024.0f) + EPS);
                float s2 = 0.f;
#pragma unroll
                for (int i = 0; i < 4; ++i) {
                    const int c0 = i * 256 + lane * 4;
                    const f32x4 ov = {bflo(ob[q][i].x), bfhi(ob[q][i].x), bflo(ob[q][i].y), bfhi(ob[q][i].y)};
                    xv[q][i] = xv[q][i] + G1[i] * ov * rstd1;
                    { u32x2 wm; wm.x = pk2(xv[q][i][0], xv[q][i][1]); wm.y = pk2(xv[q][i][2], xv[q][i][3]); *(u32x2*)(P + r * LDP + C_XM + c0) = wm; }
                    s2 += (xv[q][i][0] * xv[q][i][0] + xv[q][i][1] * xv[q][i][1]) + (xv[q][i][2] * xv[q][i][2] + xv[q][i][3] * xv[q][i][3]); }
                s2 = wave_sum(s2);
                const float rstd2 = rsqrtf(s2 * (1.0f / 1024.0f) + EPS);
#pragma unroll
                for (int i = 0; i < 4; ++i) {
                    const int c0 = i * 256 + lane * 4;
                    const f32x4 y = xv[q][i] * rstd2 * *(const f32x4*)(A2S + c0) + *(const f32x4*)(B2S + c0);
                    u32x2 w; w.x = pk2(y[0], y[1]); w.y = pk2(y[2], y[3]);
                    *(u32x2*)(P + r * LDP + C_H2 + c0) = w;
                    *(u32x2*)(HT + rloc * 2048 + (((c0 >> 3) ^ (rloc & 7)) << 4) + (c0 & 7) * 2) = w;
                }
            }
        }
        __syncthreads();
        f32x4 acc[3];
#pragma unroll
        for (int c = 0; c < 3; ++c) acc[c] = (f32x4){0.f, 0.f, 0.f, 0.f};
#pragma unroll
        for (int s = 0; s < 8; ++s) {
            const bf16x8 av = *(const bf16x8*)(HT + lr * 2048 + (((wave * 32 + s * 4 + lq) ^ (lr & 7)) << 4));
#pragma unroll
            for (int c = 0; c < 3; ++c) acc[c] = __builtin_amdgcn_mfma_f32_16x16x32_bf16(wf[s][c], av, acc[c], 0, 0, 0);
        }
        if (wave > 0) {
#pragma unroll
            for (int c = 0; c < 3; ++c) *(f32x4*)(PART + ((wave - 1) * 3 + c) * 256 + lane * 4) = acc[c];
        }
        __syncthreads();
        if (wave == 0) {
#pragma unroll
            for (int c = 0; c < 3; ++c) {
                f32x4 t = acc[c];
#pragma unroll
                for (int w = 0; w < 3; ++w) t = t + *(const f32x4*)(PART + (w * 3 + c) * 256 + lane * 4);
                *(f32x4*)(LG + lr * 48 + c * 16 + lq * 4) = t;
            }
            asm volatile("" ::: "memory");
            if (lane < 16) {
                const int t = it * 16 + lane;
                const float* lg = LG + lane * 48;
                float gl[4];
#pragma unroll
                for (int q = 0; q < 4; ++q) gl[q] = lg[q] + BIAS[q];
                int gs = 0; float gm = gl[0];
#pragma unroll
                for (int q = 1; q < 4; ++q) if (gl[q] > gm) { gm = gl[q]; gs = q; }
                float gsum = 0.f;
#pragma unroll
                for (int q = 0; q < 4; ++q) gsum += __expf(gl[q] - gm);
                const float pg = 1.0f / gsum;
                float el[8];
#pragma unroll
                for (int q = 0; q < 8; ++q) el[q] = lg[4 + gs * 8 + q] + BIAS[4 + gs * 8 + q];
                int i0 = 0; float m0 = el[0];
#pragma unroll
                for (int q = 1; q < 8; ++q) if (el[q] > m0) { m0 = el[q]; i0 = q; }
                int i1 = 0; float m1 = -3.0e38f;
#pragma unroll
                for (int q = 0; q < 8; ++q) if (q != i0 && el[q] > m1) { m1 = el[q]; i1 = q; }
                const float e1 = __expf(m1 - m0);
                const float w0 = pg / (1.0f + e1), w1 = pg * e1 / (1.0f + e1);
                const int ea = gs * 8 + i0, eb = gs * 8 + i1;
                const int sa = atomicAdd(&cnt[ea * 32], 1), sb = atomicAdd(&cnt[eb * 32], 1);
                CW[t * 2] = w0; CW[t * 2 + 1] = w1;
                LIST[(size_t)ea * S + sa] = t * 2; LIST[(size_t)eb * S + sb] = t * 2 + 1;
            }
        }
    }
}

DEVI bool moe_find_tile(const int* cl, int tile, int& e, int& j, int& base, int& ne) {
    int acc_t = 0, acc_r = 0; bool found = false; e = 0; j = 0; base = 0; ne = 0;
#pragma unroll 8
    for (int q = 0; q < NEXP; ++q) {
        const int c = cl[q], tq = (c + 127) >> 7;
        if (!found && tile < acc_t + tq) { found = true; e = q; j = tile - acc_t; base = acc_r; ne = c; }
        acc_t += tq; acc_r += c;
    }
    return found;
}
DEVI const int* moe_stage_counts(const Params& p, unsigned char* lds, int tid) {
    int* cl = (int*)(lds + 65536);
    __syncthreads();
    if (tid < NEXP) cl[tid] = ((const int*)(p.ws + WS_CNT))[tid * 32];
    __syncthreads();
    return cl;
}

static DEVI void phaseE1(const Params& p, unsigned char* lds, int tid) {
    const int lane = tid & 63, wave = __builtin_amdgcn_readfirstlane(tid >> 6), wr = wave >> 1, wc = wave & 1, lr = lane & 15, lq = lane >> 4;
    const bf16_t* P = (const bf16_t*)(p.ws + WS_P);
    const int* LIST = (const int*)(p.ws + WS_LIST);
    const float* CW = (const float*)(p.ws + WS_CW);
    const int* cnt = moe_stage_counts(p, lds, tid);
    bf16_t* ACT = (bf16_t*)(p.ws + WS_SEL);
    for (int it = blockIdx.x;; it += gridDim.x) {
        int e, j, base, ne;
        const bool ok = moe_find_tile(cnt, it >> 2, e, j, base, ne);
        if (!ok) break;
        const int nt = it & 3;
        const bf16_t* wgu = (const bf16_t*)(p.ws + WS_WGU) + (size_t)e * 512 * 1024;
        const bf16_t* ap[4]; const bf16_t* bp[4];
#pragma unroll
        for (int q = 0; q < 4; ++q) {
            int slot = j * 128 + q * 32 + (tid >> 3); slot = slot < ne ? slot : 0;
            const int tok = LIST[(size_t)e * S + slot] >> 1;
            ap[q] = P + (size_t)tok * LDP + C_H2 + gemm_kc(tid);
            bp[q] = wgu + (size_t)(nt * 128 + q * 32 + (tid >> 3)) * 1024 + gemm_kc(tid);
        }
        float cwm[4];
#pragma unroll
        for (int m = 0; m < 4; ++m) { const int slot = j * 128 + wr * 64 + m * 16 + lr; cwm[m] = CW[LIST[(size_t)e * S + (slot < ne ? slot : 0)]]; }
        f32x4 acc[4][4]; zero_acc(acc);
        gemm128(acc, ap, bp, 16, lds, tid);
#pragma unroll
        for (int m = 0; m < 4; ++m) {
            const int slot = j * 128 + wr * 64 + m * 16 + lr;
            if (slot < ne) {
                const float cw = cwm[m];
#pragma unroll
                for (int hp = 0; hp < 2; ++hp) {
                    const f32x4 g = acc[m][hp * 2], u = acc[m][hp * 2 + 1];
                    u32x2 w; w.x = pk2(siluf_(g[0]) * u[0] * cw, siluf_(g[1]) * u[1] * cw); w.y = pk2(siluf_(g[2]) * u[2] * cw, siluf_(g[3]) * u[3] * cw);
                    __hip_atomic_store((unsigned long long*)(ACT + (size_t)(base + slot) * 256 + nt * 64 + wc * 32 + hp * 16 + lq * 4), ((unsigned long long)w.y << 32) | w.x, __ATOMIC_RELAXED, __HIP_MEMORY_SCOPE_AGENT);
                }
            }
        }
        asm volatile("s_waitcnt vmcnt(0)" ::: "memory");
        __syncthreads();
        if (tid == 0) __hip_atomic_fetch_add((unsigned*)(p.ws + WS_CNT) + 1024 + (it >> 2), 1u, __ATOMIC_RELAXED, __HIP_MEMORY_SCOPE_AGENT);
    }
}

static DEVI void phaseE2(const Params& p, unsigned char* lds, int tid) {
    const int lane = tid & 63, wave = __builtin_amdgcn_readfirstlane(tid >> 6), wr = wave >> 1, wc = wave & 1, lr = lane & 15, lq = lane >> 4;
    bf16_t* P = (bf16_t*)(p.ws + WS_P);
    const int* LIST = (const int*)(p.ws + WS_LIST);
    const int* cnt = (const int*)(lds + 65536);
    const bf16_t* ACT = (const bf16_t*)(p.ws + WS_SEL);
    unsigned* queue = (unsigned*)(p.ws + WS_CNT) + 2;
    volatile int* qslot = (volatile int*)(lds + 65536 + 256);
    __syncthreads();
    if (tid == 0) *qslot = (int)__hip_atomic_fetch_add(queue, 1u, __ATOMIC_RELAXED, __HIP_MEMORY_SCOPE_AGENT);
    __syncthreads();
    int it = *qslot;
    for (;;) {
        int e, j, base, ne;
        const bool ok = moe_find_tile(cnt, it >> 3, e, j, base, ne);
        if (!ok) break;
        unsigned nxt = 0;
        if (tid == 0) {
            nxt = __hip_atomic_fetch_add(queue, 1u, __ATOMIC_RELAXED, __HIP_MEMORY_SCOPE_AGENT);
            while (__hip_atomic_load((unsigned*)(p.ws + WS_CNT) + 1024 + (it >> 3), __ATOMIC_RELAXED, __HIP_MEMORY_SCOPE_AGENT) < 4u) __builtin_amdgcn_s_sleep(2);
            __builtin_amdgcn_fence(__ATOMIC_ACQUIRE, "agent");
        }
        __syncthreads();
        const int nt = it & 7;
        const bf16_t* wd = (const bf16_t*)(p.ws + WS_WD) + (size_t)e * 1024 * 256;
        const bf16_t* ap[4]; const bf16_t* bp[4];
#pragma unroll
        for (int q = 0; q < 4; ++q) {
            int slot = j * 128 + q * 32 + (tid >> 3); slot = slot < ne ? slot : 0;
            ap[q] = ACT + (size_t)(base + slot) * 256 + gemm_kc(tid);
            bp[q] = wd + (size_t)(nt * 128 + q * 32 + (tid >> 3)) * 256 + gemm_kc(tid);
        }
        int entm[4];
#pragma unroll
        for (int m = 0; m < 4; ++m) { const int slot = j * 128 + wr * 64 + m * 16 + lr; entm[m] = LIST[(size_t)e * S + (slot < ne ? slot : 0)]; }
        f32x4 acc[4][4]; zero_acc(acc);
        gemm128(acc, ap, bp, 4, lds, tid);
#pragma unroll
        for (int m = 0; m < 4; ++m) {
            const int slot = j * 128 + wr * 64 + m * 16 + lr;
            if (slot < ne) {
                const int ent = entm[m];
                bf16_t* yrow = P + (size_t)(ent >> 1) * LDP + C_Y + (ent & 1) * 1024;
#pragma unroll
                for (int n = 0; n < 4; ++n) {
                    u32x2 w; w.x = pk2(acc[m][n][0], acc[m][n][1]); w.y = pk2(acc[m][n][2], acc[m][n][3]);
                    *(u32x2*)(yrow + nt * 128 + wc * 64 + n * 16 + lq * 4) = w;
                }
            }
        }
        if (tid == 0) *qslot = (int)nxt;
        __syncthreads();
        it = *qslot;
    }
}

static DEVI void phaseF(const Params& p, int tid) {
    const int lane = tid & 63, gw = blockIdx.x * 4 + __builtin_amdgcn_readfirstlane(tid >> 6), nw = gridDim.x * 4;
    const float* mod = (const float*)(p.ws + WS_MOD);
    const bf16_t* P = (const bf16_t*)(p.ws + WS_P);
    f32x4 G[4];
#pragma unroll
    for (int i = 0; i < 4; ++i) { const int c0 = i * 256 + lane * 4; G[i] = *(const f32x4*)(mod + 5120 + c0) * *(const f32x4*)(p.g_post_ffn + c0); }
    for (int r0 = gw; r0 < S; r0 += 2 * nw) {
        f32x4 y[2][4], xm[2][4]; float ss[2] = {0.f, 0.f};
#pragma unroll
        for (int q = 0; q < 2; ++q) {
            const int r = (r0 + q * nw < S) ? r0 + q * nw : r0;
#pragma unroll
            for (int i = 0; i < 4; ++i) {
                const u32x2 a = *(const u32x2*)(P + (size_t)r * LDP + C_Y + i * 256 + lane * 4), b = *(const u32x2*)(P + (size_t)r * LDP + C_Y + 1024 + i * 256 + lane * 4);
                const u32x2 xb = *(const u32x2*)(P + (size_t)r * LDP + C_XM + i * 256 + lane * 4);
                xm[q][i] = (f32x4){bflo(xb.x), bfhi(xb.x), bflo(xb.y), bfhi(xb.y)};
                y[q][i][0] = bflo(a.x) + bflo(b.x); y[q][i][1] = bfhi(a.x) + bfhi(b.x); y[q][i][2] = bflo(a.y) + bflo(b.y); y[q][i][3] = bfhi(a.y) + bfhi(b.y);
            }
        }
#pragma unroll
        for (int q = 0; q < 2; ++q) {
#pragma unroll
            for (int i = 0; i < 4; ++i) ss[q] += (y[q][i][0] * y[q][i][0] + y[q][i][1] * y[q][i][1]) + (y[q][i][2] * y[q][i][2] + y[q][i][3] * y[q][i][3]);
            ss[q] = wave_sum(ss[q]);
        }
#pragma unroll
        for (int q = 0; q < 2; ++q) {
            const int r = r0 + q * nw;
            if (r < S) {
                const float rstd = rsqrtf(ss[q] * (1.0f / 1024.0f) + EPS);
#pragma unroll
                for (int i = 0; i < 4; ++i) *(f32x4*)(p.out + (size_t)r * D + i * 256 + lane * 4) = xm[q][i] + G[i] * y[q][i] * rstd;
            }
        }
    }
}

#ifndef STOP_AFTER_MIXER
#define STOP_AFTER_MIXER 0
#endif
__global__ void __launch_bounds__(NT, 2) mega(Params p) {
    __shared__ __attribute__((aligned(16))) unsigned char lds[LDS_BYTES];
    cg::grid_group grid = cg::this_grid();
    int tid = threadIdx.x;
    const int wv64 = __builtin_amdgcn_readfirstlane(tid & ~63);
#define FRESH_TID() do { int l_; asm volatile("v_mbcnt_lo_u32_b32 %0, -1, 0\n\tv_mbcnt_hi_u32_b32 %0, -1, %0" : "=v"(l_)); tid = wv64 + l_; } while (0)
    uint4* xb_words = (uint4*)(lds + LDS_BYTES - 16);
    if (tid == 0) *xb_words = make_uint4(0u, 0u, 0u, 0u);
    __syncthreads();
    if (p.out == nullptr) grid.sync();
    XcdBarrier xb = xcd_barrier_post((unsigned*)(p.ws + WS_BAR), (volatile LAS unsigned*)xb_words);
    FRESH_TID();
    phase0(p, lds, tid);
    FRESH_TID();
    phase1(p, tid);
    xcd_barrier(xb);
    FRESH_TID();
    phase2(p, lds, tid);
    xcd_barrier(xb);
    FRESH_TID();
    for (int it = blockIdx.x; it < 1024; it += gridDim.x) gla_item<false>(p, it, lds, tid);
    __syncthreads();
    FRESH_TID();
    topk_phase(p, lds, tid);
    xcd_barrier(xb);
    FRESH_TID();
    gla_scan(p, tid);
    xcd_barrier(xb);
    FRESH_TID();
    for (int it = blockIdx.x; it < 1024; it += gridDim.x) gla_item<true>(p, it, lds, tid);
    __syncthreads();
    FRESH_TID();
    sa_phase(p, lds, tid);
    xcd_barrier(xb);
    FRESH_TID();
    phaseM1<true>(p, lds, tid);
    xcd_barrier(xb);
    FRESH_TID();
    phaseM2(p, lds, tid);
    xcd_barrier(xb);
    FRESH_TID();
    phaseM3(p, lds, tid);
    xcd_barrier(xb);
    FRESH_TID();
    phaseE1(p, lds, tid);
    FRESH_TID();
    phaseE2(p, lds, tid);
    xcd_barrier(xb);
    FRESH_TID();
    phaseF(p, tid);
}

extern "C" void kernel_launch(void* const* d_in, const int* in_sizes, int n_in, void* d_out, int out_size, void* d_ws, size_t ws_size, hipStream_t stream) {
    static int grid_blocks = 0;
    if (!grid_blocks) {
        int dev = 0, cus = 0, per_cu = 0;
        hipGetDevice(&dev);
        hipDeviceGetAttribute(&cus, hipDeviceAttributeMultiprocessorCount, dev);
        hipOccupancyMaxActiveBlocksPerMultiprocessor(&per_cu, mega, NT, 0);
        if (per_cu > 2) per_cu = 2;
        if (per_cu < 1) per_cu = 1;
        grid_blocks = cus * per_cu;
        if (ws_size < WS_END) fprintf(stderr, "kernel_launch: workspace too small: %zu < %zu\n", ws_size, (size_t)WS_END);
    }
    Params p{};
    p.x = (const float*)d_in[0]; p.c = (const float*)d_in[1]; p.pos = (const int*)d_in[2]; p.w_ada = (const float*)d_in[3]; p.b_ada = (const float*)d_in[4];
    p.g_pre_mix = (const float*)d_in[5]; p.g_post_mix = (const float*)d_in[6]; p.g_pre_ffn = (const float*)d_in[7]; p.g_post_ffn = (const float*)d_in[8];
    p.w_in = (const float*)d_in[9]; p.w_gla_a2 = (const float*)d_in[10]; p.b_gla_a = (const float*)d_in[11]; p.g_gla_out = (const float*)d_in[12]; p.g_idx_k = (const float*)d_in[13];
    p.w_proj_gla = (const float*)d_in[14]; p.w_proj_dsa = (const float*)d_in[15]; p.w_out = (const float*)d_in[16];
    p.w_rg = (const float*)d_in[17]; p.b_rg = (const float*)d_in[18]; p.w_re = (const float*)d_in[19]; p.b_re = (const float*)d_in[20];
    p.w_eg = (const float*)d_in[21]; p.w_eu = (const float*)d_in[22]; p.w_ed = (const float*)d_in[23];
    p.out = (float*)d_out; p.ws = (unsigned char*)d_ws;
    (void)hipMemsetAsync((unsigned char*)d_ws + WS_CNT, 0, 8192 + XCD_BAR_WORDS * 4, stream);
    void* args[] = {&p};
    hipError_t e = hipLaunchCooperativeKernel((void*)mega, dim3(grid_blocks), dim3(NT), args, 0, stream);
    if (e != hipSuccess) fprintf(stderr, "cooperative launch failed: %s (grid %d)\n", hipGetErrorString(e), grid_blocks);
}
```

```cpp
#include <hip/hip_runtime.h>
#include <hip/hip_cooperative_groups.h>
#include <cstdio>
#include <cstdint>
namespace cg = cooperative_groups;

#define DEVI __device__ __forceinline__
typedef unsigned short bf16_t;
typedef short bf16x8 __attribute__((ext_vector_type(8)));
typedef float f32x4 __attribute__((ext_vector_type(4)));
typedef float f32x16 __attribute__((ext_vector_type(16)));
typedef unsigned u32x4 __attribute__((ext_vector_type(4)));
typedef unsigned u32x2 __attribute__((ext_vector_type(2)));

constexpr int S = 16384, D = 1024, DIN = 5720;
constexpr int LDP = 5760;
constexpr int C_GQ = 0, C_GK = 256, C_GV = 512, C_GG = 1024, C_DQ = 1536, C_DK = 2048, C_DV = 2560, C_IQ = 3072, C_BG = 3584, C_IK = 5632, C_GA = 5696, C_IW = 5712;
constexpr int C_OA = C_GG, C_OB = C_DQ;
constexpr int C_XM = 1024;
constexpr int C_H2 = 2048;
constexpr int C_Y = 3072;
constexpr float EPS = 1e-6f;
constexpr int NEXP = 32, DEXP = 256;

constexpr size_t WS_P    = 0;
constexpr size_t WS_WGU  = WS_P + (size_t)S * LDP * 2;
constexpr size_t WS_WD   = WS_WGU + (size_t)NEXP * 512 * 1024 * 2;
constexpr size_t WS_SEL  = WS_WD + (size_t)NEXP * 1024 * 256 * 2;
constexpr size_t WS_KI   = WS_SEL + (size_t)16 * 1024 * 1024;
constexpr size_t WS_AUX  = WS_KI + (size_t)S * 64 * 2;
constexpr size_t WS_ROPE = WS_AUX + (size_t)S * 32 * 4;
constexpr size_t WS_LIST = WS_ROPE + (size_t)S * 8 * 8;
constexpr size_t WS_MOD  = WS_LIST + (size_t)NEXP * S * 4;
constexpr size_t WS_SELC = WS_MOD + 6144 * 4;
constexpr size_t WS_CW   = WS_SELC + (size_t)S * 4;
constexpr size_t WS_CNT  = WS_CW + (size_t)S * 2 * 4;
constexpr size_t WS_BAR  = WS_CNT + 8192;
constexpr size_t WS_WRT  = WS_BAR + 3456 * 4;
constexpr size_t WS_SKT  = WS_WRT + 48 * 1024 * 4;
constexpr size_t WS_END  = WS_SKT + (size_t)8 * S * 2;
constexpr size_t DO_H    = 0;
constexpr size_t DO_WIN  = (size_t)32 * 1024 * 1024;
constexpr size_t DO_WPG  = (size_t)44 * 1024 * 1024;
constexpr size_t DO_WPD  = (size_t)45 * 1024 * 1024;
constexpr size_t DO_WOUT = (size_t)46 * 1024 * 1024;
constexpr size_t DO_GD   = (size_t)52 * 1024 * 1024;

constexpr int NT = 256;
constexpr int LDS_BYTES = 77824;

struct Params {
    const float* x; const float* c; const int* pos; const float* w_ada; const float* b_ada;
    const float* g_pre_mix; const float* g_post_mix; const float* g_pre_ffn; const float* g_post_ffn;
    const float* w_in; const float* w_gla_a2; const float* b_gla_a; const float* g_gla_out; const float* g_idx_k;
    const float* w_proj_gla; const float* w_proj_dsa; const float* w_out;
    const float* w_rg; const float* b_rg; const float* w_re; const float* b_re;
    const float* w_eg; const float* w_eu; const float* w_ed;
    float* out; unsigned char* ws;
};

typedef __bf16 bf16v2_t __attribute__((ext_vector_type(2)));
typedef float f32x2_t __attribute__((ext_vector_type(2)));
typedef short s16x2_t __attribute__((ext_vector_type(2)));
DEVI unsigned pk2(float lo, float hi) { f32x2_t v = {lo, hi}; bf16v2_t r = __builtin_convertvector(v, bf16v2_t); return __builtin_bit_cast(unsigned, r); }
DEVI unsigned f2bf(float f) { return pk2(f, 0.f) & 0xffffu; }
DEVI float bf2f(unsigned h) { return __uint_as_float(h << 16); }
DEVI unsigned relu2_bf16(unsigned x) { s16x2_t v = __builtin_bit_cast(s16x2_t, x); const s16x2_t z = {0, 0}; v = __builtin_elementwise_max(v, z); return __builtin_bit_cast(unsigned, v); }
extern "C" __device__ unsigned __ockl_wfred_max_u32(unsigned);
DEVI float bflo(unsigned w) { return __uint_as_float(w << 16); }
DEVI float bfhi(unsigned w) { return __uint_as_float(w & 0xffff0000u); }
extern "C" __device__ float __ockl_wfred_add_f32(float);
DEVI float wave_sum(float v) { return __ockl_wfred_add_f32(v); }
DEVI float sigmoidf_(float z) { return __builtin_amdgcn_rcpf(1.0f + __builtin_amdgcn_exp2f(-1.4426950408889634f * z)); }
DEVI float siluf_(float z) { return z * __builtin_amdgcn_rcpf(1.0f + __builtin_amdgcn_exp2f(-1.4426950408889634f * z)); }

DEVI int tile_off(int row, int chunk) { return row * 128 + ((chunk ^ (row & 7)) << 4); }

DEVI int gemm_kc(int tid) { return ((tid & 7) ^ ((tid >> 3) & 7)) * 8; }
typedef __attribute__((address_space(3))) unsigned lds_u32_t;
DEVI void gemm128(f32x4 (&acc)[4][4], const bf16_t* const (&ap)[4], const bf16_t* const (&bp)[4], int KT, unsigned char* lds, int tid) {
    const int lane = tid & 63, wave = __builtin_amdgcn_readfirstlane(tid >> 6), wr = wave >> 1, wc = wave & 1;
#pragma unroll
    for (int p = 0; p < 4; ++p) {
        __builtin_amdgcn_global_load_lds((const unsigned*)ap[p], (lds_u32_t*)(lds + (p * 256 + wave * 64) * 16), 16, 0, 0);
        __builtin_amdgcn_global_load_lds((const unsigned*)bp[p], (lds_u32_t*)(lds + 16384 + (p * 256 + wave * 64) * 16), 16, 0, 0);
    }
    __syncthreads();
    for (int kt = 0; kt < KT; ++kt) {
        unsigned char* As = lds + (kt & 1) * 32768;
        unsigned char* Bs = As + 16384;
        if (kt + 1 < KT) {
            unsigned char* An = lds + ((kt + 1) & 1) * 32768;
#pragma unroll
            for (int p = 0; p < 4; ++p) {
                __builtin_amdgcn_global_load_lds((const unsigned*)(ap[p] + (kt + 1) * 64), (lds_u32_t*)(An + (p * 256 + wave * 64) * 16), 16, 0, 0);
                __builtin_amdgcn_global_load_lds((const unsigned*)(bp[p] + (kt + 1) * 64), (lds_u32_t*)(An + 16384 + (p * 256 + wave * 64) * 16), 16, 0, 0);
            }
        }
#pragma unroll
        for (int ks = 0; ks < 2; ++ks) {
            bf16x8 a[4], b[4];
#pragma unroll
            for (int m = 0; m < 4; ++m) a[m] = *(const bf16x8*)(As + tile_off(wr * 64 + m * 16 + (lane & 15), ks * 4 + (lane >> 4)));
#pragma unroll
            for (int n = 0; n < 4; ++n) b[n] = *(const bf16x8*)(Bs + tile_off(wc * 64 + n * 16 + (lane & 15), ks * 4 + (lane >> 4)));
#pragma unroll
            for (int m = 0; m < 4; ++m)
#pragma unroll
                for (int n = 0; n < 4; ++n) acc[m][n] = __builtin_amdgcn_mfma_f32_16x16x32_bf16(b[n], a[m], acc[m][n], 0, 0, 0);
        }
        __syncthreads();
    }
}

DEVI void gemm128p(f32x4 (&acc)[4][4], const bf16_t* const (&ap)[4], const bf16_t* const (&bp)[4], int KT, unsigned char* lds, int tid,
                   int& par, bool pre, const bf16_t* const (&nap)[4], const bf16_t* const (&nbp)[4], bool has_next) {
    const int lane = tid & 63, wave = __builtin_amdgcn_readfirstlane(tid >> 6), wr = wave >> 1, wc = wave & 1;
    if (!pre) {
        unsigned char* A0 = lds + par * 32768;
#pragma unroll
        for (int p = 0; p < 4; ++p) {
            __builtin_amdgcn_global_load_lds((const unsigned*)ap[p], (lds_u32_t*)(A0 + (p * 256 + wave * 64) * 16), 16, 0, 0);
            __builtin_amdgcn_global_load_lds((const unsigned*)bp[p], (lds_u32_t*)(A0 + 16384 + (p * 256 + wave * 64) * 16), 16, 0, 0);
        }
        __syncthreads();
    }
    for (int kt = 0; kt < KT; ++kt) {
        const int cur = (par + kt) & 1;
        unsigned char* As = lds + cur * 32768;
        unsigned char* Bs = As + 16384;
        unsigned char* An = lds + (cur ^ 1) * 32768;
        if (kt + 1 < KT) {
#pragma unroll
            for (int p = 0; p < 4; ++p) {
                __builtin_amdgcn_global_load_lds((const unsigned*)(ap[p] + (kt + 1) * 64), (lds_u32_t*)(An + (p * 256 + wave * 64) * 16), 16, 0, 0);
                __builtin_amdgcn_global_load_lds((const unsigned*)(bp[p] + (kt + 1) * 64), (lds_u32_t*)(An + 16384 + (p * 256 + wave * 64) * 16), 16, 0, 0);
            }
        } else if (has_next) {
#pragma unroll
            for (int p = 0; p < 4; ++p) {
                __builtin_amdgcn_global_load_lds((const unsigned*)nap[p], (lds_u32_t*)(An + (p * 256 + wave * 64) * 16), 16, 0, 0);
                __builtin_amdgcn_global_load_lds((const unsigned*)nbp[p], (lds_u32_t*)(An + 16384 + (p * 256 + wave * 64) * 16), 16, 0, 0);
            }
        }
#pragma unroll
        for (int ks = 0; ks < 2; ++ks) {
            bf16x8 a[4], b[4];
#pragma unroll
            for (int m = 0; m < 4; ++m) a[m] = *(const bf16x8*)(As + tile_off(wr * 64 + m * 16 + (lane & 15), ks * 4 + (lane >> 4)));
#pragma unroll
            for (int n = 0; n < 4; ++n) b[n] = *(const bf16x8*)(Bs + tile_off(wc * 64 + n * 16 + (lane & 15), ks * 4 + (lane >> 4)));
#pragma unroll
            for (int m = 0; m < 4; ++m)
#pragma unroll
                for (int n = 0; n < 4; ++n) acc[m][n] = __builtin_amdgcn_mfma_f32_16x16x32_bf16(b[n], a[m], acc[m][n], 0, 0, 0);
        }
        __syncthreads();
    }
    par = (par + KT) & 1;
}

DEVI int bperm(int R) { return (R & 64) | (((R & 15) >> 2) << 4) | (((R >> 4) & 3) << 2) | (R & 3); }
DEVI void zero_acc(f32x4 (&acc)[4][4]) {
#pragma unroll
    for (int m = 0; m < 4; ++m)
#pragma unroll
        for (int n = 0; n < 4; ++n) acc[m][n] = (f32x4){0.f, 0.f, 0.f, 0.f};
}

DEVI void gemm256b(f32x4 (&acc)[8][4], const bf16_t* a0, const bf16_t* b0, int lda, int ldb, int KT  , unsigned char* lds, int tid,
                   bool pre, int dna, int dnb, bool has_next) {
    const int lane = tid & 63, wave = __builtin_amdgcn_readfirstlane(tid >> 6), wr = wave >> 1, wc = wave & 1;
    auto issueA = [&](const bf16_t* src) {
#pragma unroll
        for (int p = 0; p < 8; ++p) __builtin_amdgcn_global_load_lds((const unsigned*)(src + (size_t)p * 32 * lda), (lds_u32_t*)(lds + (p * 256 + wave * 64) * 16), 16, 0, 0);
    };
    auto issueB = [&](const bf16_t* src, int buf) {
        unsigned char* Bn = lds + 32768 + buf * 16384;
#pragma unroll
        for (int p = 0; p < 4; ++p) __builtin_amdgcn_global_load_lds((const unsigned*)(src + (size_t)p * 32 * ldb), (lds_u32_t*)(Bn + (p * 256 + wave * 64) * 16), 16, 0, 0);
    };
    if (!pre) { issueA(a0); issueB(b0, 0); }
    for (int kt = 0; kt < KT; ++kt) {
        __syncthreads();
        if (kt + 1 < KT) issueB(b0 + (kt + 1) * 64, (kt + 1) & 1);
        const unsigned char* Bs = lds + 32768 + (kt & 1) * 16384;
        bf16x8 a[8], b[4];
#pragma unroll
        for (int m = 0; m < 8; ++m) a[m] = *(const bf16x8*)(lds + tile_off(wr * 128 + m * 16 + (lane & 15), lane >> 4));
#pragma unroll
        for (int n = 0; n < 4; ++n) b[n] = *(const bf16x8*)(Bs + tile_off(wc * 64 + n * 16 + (lane & 15), lane >> 4));
#pragma unroll
        for (int m = 0; m < 8; ++m)
#pragma unroll
            for (int n = 0; n < 4; ++n) acc[m][n] = __builtin_amdgcn_mfma_f32_16x16x32_bf16(b[n], a[m], acc[m][n], 0, 0, 0);
#pragma unroll
        for (int m = 0; m < 8; ++m) a[m] = *(const bf16x8*)(lds + tile_off(wr * 128 + m * 16 + (lane & 15), 4 + (lane >> 4)));
#pragma unroll
        for (int n = 0; n < 4; ++n) b[n] = *(const bf16x8*)(Bs + tile_off(wc * 64 + n * 16 + (lane & 15), 4 + (lane >> 4)));
        asm volatile("" ::: "memory");
        __builtin_amdgcn_s_waitcnt(0xC07F);
        __builtin_amdgcn_s_barrier();
        asm volatile("" ::: "memory");
        if (kt + 1 < KT) issueA(a0 + (kt + 1) * 64);
#pragma unroll
        for (int m = 0; m < 8; ++m)
#pragma unroll
            for (int n = 0; n < 4; ++n) acc[m][n] = __builtin_amdgcn_mfma_f32_16x16x32_bf16(b[n], a[m], acc[m][n], 0, 0, 0);
    }
    __syncthreads();
    if (has_next) { issueA(a0 + dna); issueB(b0 + dnb, 0); }
}

#define XB_TMO      128
#define XB_XCNT(j)  (256  + 64 * (j))
#define XB_XSUB(j)  (1280 + 64 * (j))
#define XB_XGEN(j)  (2304 + 64 * (j))
#define XB_TOP      3328
#define XB_TOPGEN   3392
#define XCD_BAR_WORDS 3456
#define XB_SPIN_CAP (1u << 20)
#define LAS __attribute__((address_space(3)))
DEVI unsigned xb_ld(unsigned* p)              { return __hip_atomic_load(p, __ATOMIC_RELAXED, __HIP_MEMORY_SCOPE_AGENT); }
DEVI unsigned xb_add(unsigned* p, unsigned v) { return __hip_atomic_fetch_add(p, v, __ATOMIC_RELAXED, __HIP_MEMORY_SCOPE_AGENT); }
DEVI unsigned xb_xcc_id() { return (unsigned)__builtin_amdgcn_s_getreg((3 << 11) | 20) & 0xFu; }
#define XB_SPIN(cond, bar) do { unsigned _sp = 0; while (cond) { __builtin_amdgcn_s_sleep(1); \
    if ((++_sp & 255u) == 0u) { if (xb_ld(&(bar)[XB_TMO])) break; if (_sp > XB_SPIN_CAP) { atomicAdd(&(bar)[XB_TMO], 1u); break; } } } } while (0)
struct XcdBarrier { unsigned* bar; unsigned x; volatile LAS unsigned* st; };
DEVI XcdBarrier xcd_barrier_post(unsigned* bar, volatile LAS unsigned* st) {
    XcdBarrier b; b.bar = bar; b.x = xb_xcc_id(); b.st = st;
    if (threadIdx.x == 0) (void)xb_add(&bar[XB_XCNT(b.x)], 1u);
    return b;
}
DEVI void xcd_barrier_complete(unsigned* bar, unsigned x, unsigned& nloc, unsigned& nx) {
    const unsigned G = gridDim.x * gridDim.y * gridDim.z;
    unsigned sum, cnt, mine, sp = 0u;
    for (;;) {
        sum = 0u; cnt = 0u; mine = 0u;
#pragma unroll
        for (unsigned j = 0; j < 16; ++j) { const unsigned c = xb_ld(&bar[XB_XCNT(j)]); sum += c; cnt += (c > 0u) ? 1u : 0u; mine = (j == x) ? c : mine; }
        if (sum == G) break;
        __builtin_amdgcn_s_sleep(1);
        if ((++sp & 255u) == 0u) { if (xb_ld(&bar[XB_TMO])) break; if (sp > XB_SPIN_CAP) { atomicAdd(&bar[XB_TMO], 1u); break; } }
    }
    nloc = mine > 0u ? mine : 1u; nx = cnt > 0u ? cnt : 1u;
}
DEVI void xcd_barrier(const XcdBarrier& b) {
    asm volatile("s_waitcnt vmcnt(0)" ::: "memory");
    __syncthreads();
    if (threadIdx.x == 0) {
        unsigned* bar = b.bar;
        __builtin_amdgcn_s_waitcnt(0);
        unsigned nloc = b.st[0], nx = b.st[1];
        if (nloc == 0u) { xcd_barrier_complete(bar, b.x, nloc, nx); b.st[0] = nloc; b.st[1] = nx; }
        const unsigned old = xb_add(&bar[XB_XSUB(b.x)], 1u);
        const unsigned gen = old / nloc;
        if (old + 1u == (gen + 1u) * nloc) {
            __builtin_amdgcn_fence(__ATOMIC_RELEASE, "agent");
            asm volatile("s_waitcnt vmcnt(0)" ::: "memory");
            const unsigned og = xb_add(&bar[XB_TOP], 1u);
            const unsigned tg = og / nx;
            if (og + 1u == (tg + 1u) * nx) xb_add(&bar[XB_TOPGEN], 1u);
            else XB_SPIN(xb_ld(&bar[XB_TOPGEN]) == tg, bar);
            __builtin_amdgcn_fence(__ATOMIC_ACQUIRE, "agent");
            xb_add(&bar[XB_XGEN(b.x)], 1u);
            asm volatile("s_waitcnt vmcnt(0)" ::: "memory");
        } else {
            XB_SPIN(xb_ld(&bar[XB_XGEN(b.x)]) == gen, bar);
            __builtin_amdgcn_fence(__ATOMIC_ACQUIRE, "agent");
            asm volatile("s_waitcnt vmcnt(0)" ::: "memory");
        }
    }
    __syncthreads();
}

DEVI int win_src_col(int n) {
    if (n < 1536) return n;
    if (n < 3584) return n + 16;
    if (n < 5632) return n + 88;
    if (n < 5696) return n - 5632 + 3600;
    if (n < 5712) return n - 5696 + 1536;
    if (n < 5720) return n - 5712 + 3664;
    return -1;
}

struct TDesc { const float* sp; int ld; bf16_t* dst; int ld_dst; int n0, k0; };
DEVI TDesc tile_desc(const Params& p, int it, int tid) {
    constexpr int T0 = 1440, T1 = T0 + 128, T2 = T1 + 128, T3 = T2 + 256, T4 = T3 + 4096;
    unsigned char* dout = (unsigned char*)p.out;
    TDesc d; const int nn = (tid & 15) * 4;
    if (it < T0) {
        d.n0 = (it >> 4) * 64; d.k0 = (it & 15) * 64; d.ld = DIN; d.dst = (bf16_t*)(dout + DO_WIN); d.ld_dst = 1024;
        const int sc = win_src_col(d.n0 + nn);
        d.sp = sc >= 0 ? p.w_in + sc : nullptr;
    } else if (it < T2) {
        const bool second = it >= T1; const int j = it - (second ? T1 : T0);
        d.n0 = (j >> 3) * 64; d.k0 = (j & 7) * 64; d.ld = 1024; d.dst = (bf16_t*)(dout + (second ? DO_WPD : DO_WPG)); d.ld_dst = 512;
        d.sp = (second ? p.w_proj_dsa : p.w_proj_gla) + d.n0 + nn;
    } else if (it < T3) {
        const int j = it - T2;
        d.n0 = (j >> 4) * 64; d.k0 = (j & 15) * 64; d.ld = 1024; d.dst = (bf16_t*)(dout + DO_WOUT); d.ld_dst = 1024;
        d.sp = p.w_out + d.n0 + nn;
    } else if (it < T4) {
        const int j = it - T3, e = j >> 7, r = j & 127;
        d.n0 = (r >> 4) * 64; d.k0 = (r & 15) * 64; d.ld = 256; d.dst = (bf16_t*)(p.ws + WS_WGU) + (size_t)e * 512 * 1024; d.ld_dst = 1024;
        const int n = d.n0 + nn, ns = (n >> 4) & 3, f = (n >> 7) * 64 + ((n >> 6) & 1) * 32 + (ns >> 1) * 16 + (n & 15);
        d.sp = ((ns & 1) ? p.w_eu : p.w_eg) + (size_t)e * 1024 * 256 + f;
    } else {
        const int j = it - T4, e = j >> 6, r = j & 63;
        d.n0 = (r >> 2) * 64; d.k0 = (r & 3) * 64; d.ld = 1024; d.dst = (bf16_t*)(p.ws + WS_WD) + (size_t)e * 1024 * 256; d.ld_dst = 256;
        d.sp = p.w_ed + (size_t)e * 256 * 1024 + d.n0 + nn;
    }
    return d;
}
DEVI void tile_load(const TDesc& d, f32x4 (&v4)[4], int tid) {
#pragma unroll
    for (int i = 0; i < 4; ++i) v4[i] = d.sp ? *(const f32x4*)(d.sp + (size_t)(d.k0 + i * 16 + (tid >> 4)) * d.ld) : (f32x4){0.f, 0.f, 0.f, 0.f};
}
DEVI void tile_finish(const TDesc& d, const f32x4 (&v4)[4], float* tl  , int tid) {
    __syncthreads();
#pragma unroll
    for (int i = 0; i < 4; ++i) {
        const int kk = i * 16 + (tid >> 4), nn = (tid & 15) * 4;
        tl[kk * 65 + nn] = v4[i][0]; tl[kk * 65 + nn + 1] = v4[i][1]; tl[kk * 65 + nn + 2] = v4[i][2]; tl[kk * 65 + nn + 3] = v4[i][3];
    }
    __syncthreads();
#pragma unroll
    for (int p2 = 0; p2 < 2; ++p2) {
        const int nn = p2 * 32 + (tid >> 3), ch = tid & 7;
        float v[8];
#pragma unroll
        for (int j = 0; j < 8; ++j) v[j] = tl[(ch * 8 + j) * 65 + nn];
        u32x4 w; w.x = pk2(v[0], v[1]); w.y = pk2(v[2], v[3]); w.z = pk2(v[4], v[5]); w.w = pk2(v[6], v[7]);
        *(u32x4*)(d.dst + (size_t)(d.n0 + nn) * d.ld_dst + d.k0 + ch * 8) = w;
    }
}

static DEVI void phase0(const Params& p, unsigned char* lds, int tid) {
    float* tl = (float*)lds;
    const int nb = gridDim.x, b = blockIdx.x;
    unsigned char* dout = (unsigned char*)p.out;
    for (int it = b; it < 192; it += nb) {
        const int col = it * 32 + (tid & 31), kg = tid >> 5;
        float s = 0.f;
        for (int k0 = 0; k0 < 1024; k0 += 128) {
            float wv[16], cv[16];
#pragma unroll
            for (int j = 0; j < 16; ++j) { const int k = k0 + j * 8 + kg; wv[j] = p.w_ada[(size_t)k * 6144 + col]; cv[j] = p.c[k]; }
#pragma unroll
            for (int j = 0; j < 16; ++j) s += siluf_(cv[j]) * wv[j];
        }
        __syncthreads();
        tl[tid] = s;
        __syncthreads();
        if (tid < 32) {
            float t = 0.f;
#pragma unroll
            for (int g = 0; g < 8; ++g) t += tl[g * 32 + tid];
            ((float*)(p.ws + WS_MOD))[col] = t + p.b_ada[col];
            __threadfence();
        }
        if (it < 64) {
            __syncthreads();
            if (tid == 0) __hip_atomic_fetch_add((unsigned*)(p.ws + WS_CNT) + 1, 1u, __ATOMIC_RELEASE, __HIP_MEMORY_SCOPE_AGENT);
        }
    }
    for (int it = b; it < 192; it += nb) {
        const int e = it * 256 + tid, row = e >> 10, k = e & 1023;
        float v = 0.f;
        if (row < 4) v = p.w_rg[(size_t)k * 4 + row]; else if (row < 36) v = p.w_re[(size_t)k * 32 + (row - 4)];
        ((bf16_t*)(p.ws + WS_WRT))[e] = (bf16_t)(pk2(v, 0.f) & 0xffffu);
    }
    for (int it = b; it < 512; it += nb) {
        const int e = it * 256 + tid, t = e >> 3, i = e & 7;
        const double fr[8] = {1.0, 0.19392274474868576, 0.03760603093086393, 0.007292664737217109, 0.001414213562373095, 0.0002742481756762073, 5.318295896944988e-05, 1.031338537721246e-05};
        double f = fr[0];
#pragma unroll
        for (int q = 1; q < 8; ++q) f = (i == q) ? fr[q] : f;
        const float ang32 = (float)p.pos[t] * (float)f;
        const double rev = (double)ang32 * 0.15915494309189535;
        const float fracr = (float)(rev - floor(rev));
        float2 cs; cs.x = __builtin_amdgcn_cosf(fracr); cs.y = __builtin_amdgcn_sinf(fracr);
        ((float2*)(p.ws + WS_ROPE))[e] = cs;
    }
    constexpr int T5 = 1440 + 128 + 128 + 256 + 4096 + 2048;
    if (b < T5) {
        TDesc d = tile_desc(p, b, tid);
        f32x4 v4[4]; tile_load(d, v4, tid);
        for (int it = b; it < T5; it += nb) {
            const int itn = it + nb;
            TDesc dn = d; f32x4 vn[4];
            if (itn < T5) { dn = tile_desc(p, itn, tid); tile_load(dn, vn, tid); }
            tile_finish(d, v4, tl, tid);
            if (itn < T5) {
                d = dn;
#pragma unroll
                for (int i = 0; i < 4; ++i) v4[i] = vn[i];
            }
        }
    }
}

static DEVI void phase1(const Params& p, int tid) {
    const int lane = tid & 63, gw = blockIdx.x * 4 + __builtin_amdgcn_readfirstlane(tid >> 6), nw = gridDim.x * 4;
    const float* mod = (const float*)(p.ws + WS_MOD);
    bf16_t* h = (bf16_t*)((unsigned char*)p.out + DO_H);
    if (tid == 0) { while (__hip_atomic_load((unsigned*)(p.ws + WS_CNT) + 1, __ATOMIC_ACQUIRE, __HIP_MEMORY_SCOPE_AGENT) < 64u) __builtin_amdgcn_s_sleep(2); }
    __syncthreads();
    f32x4 A[4], B[4];
#pragma unroll
    for (int i = 0; i < 4; ++i) {
        const int c0 = i * 256 + lane * 4;
        const f32x4 g = *(const f32x4*)(p.g_pre_mix + c0), sc = *(const f32x4*)(mod + 1024 + c0);
        A[i] = g * (sc + 1.0f); B[i] = *(const f32x4*)(mod + c0);
    }
    for (int r = gw; r < S; r += 2 * nw) {
        const int r1 = r + nw; const bool has1 = r1 < S;
        f32x4 v[4], u[4]; float ss = 0.f, su = 0.f;
#pragma unroll
        for (int i = 0; i < 4; ++i) { v[i] = *(const f32x4*)(p.x + (size_t)r * D + i * 256 + lane * 4); u[i] = *(const f32x4*)(p.x + (size_t)(has1 ? r1 : r) * D + i * 256 + lane * 4); }
#pragma unroll
        for (int i = 0; i < 4; ++i) { ss += v[i][0] * v[i][0] + v[i][1] * v[i][1] + v[i][2] * v[i][2] + v[i][3] * v[i][3]; su += u[i][0] * u[i][0] + u[i][1] * u[i][1] + u[i][2] * u[i][2] + u[i][3] * u[i][3]; }
        ss = wave_sum(ss); su = wave_sum(su);
        const float rstd = rsqrtf(ss * (1.0f / 1024.0f) + EPS), rstu = rsqrtf(su * (1.0f / 1024.0f) + EPS);
#pragma unroll
        for (int i = 0; i < 4; ++i) {
            const f32x4 y = v[i] * rstd * A[i] + B[i];
            u32x2 w; w.x = pk2(y[0], y[1]); w.y = pk2(y[2], y[3]);
            *(u32x2*)(h + (size_t)r * D + i * 256 + lane * 4) = w;
            if (has1) {
                const f32x4 z = u[i] * rstu * A[i] + B[i];
                u32x2 w1; w1.x = pk2(z[0], z[1]); w1.y = pk2(z[2], z[3]);
                *(u32x2*)(h + (size_t)r1 * D + i * 256 + lane * 4) = w1;
            }
        }
    }
}

static DEVI void phase2(const Params& p, unsigned char* lds, int tid) {
    const int lane = tid & 63, wave = __builtin_amdgcn_readfirstlane(tid >> 6), wr = wave >> 1, wc = wave & 1;
    const int lr = lane & 15, lq = lane >> 4;
    const bf16_t* h = (const bf16_t*)((unsigned char*)p.out + DO_H);
    const bf16_t* wt = (const bf16_t*)((unsigned char*)p.out + DO_WIN);
    bf16_t* P = (bf16_t*)(p.ws + WS_P);
    bf16_t* KI = (bf16_t*)(p.ws + WS_KI);
    float* AUX = (float*)(p.ws + WS_AUX);
    const float2* rope = (const float2*)(p.ws + WS_ROPE);
    bool pre = false;
    for (int i = blockIdx.x; i < 2880; i += gridDim.x) {
        const int xcd = i & 7, j = i >> 3, nt = j >> 3, mt = xcd * 8 + (j & 7);
        const int inx = i + gridDim.x; const bool has_next = inx < 2880;
        const int jn = (has_next ? inx : i) >> 3, ntn = jn >> 3, mtn = xcd * 8 + (jn & 7);
        f32x4 acc[8][4];
#pragma unroll
        for (int m = 0; m < 8; ++m)
#pragma unroll
            for (int n = 0; n < 4; ++n) acc[m][n] = (f32x4){0.f, 0.f, 0.f, 0.f};
        gemm256b(acc, h + (size_t)(mt * 256 + (tid >> 3)) * D + gemm_kc(tid), wt + (size_t)(nt * 128 + (tid >> 3)) * D + gemm_kc(tid), D, D, 16, lds, tid,
                 pre, (mtn - mt) * 256 * D, (ntn - nt) * 128 * D, has_next);
        pre = has_next;
        const int colw = nt * 128 + wc * 64;
        int kind;
        if (nt < 2) kind = 1; else if (nt < 12) kind = 0; else if (nt < 16) kind = 3; else if (nt < 20) kind = 2; else if (nt < 24) kind = 0; else if (nt < 28) kind = 2;
        else if (nt < 44) kind = 4; else kind = (wc == 0) ? 5 : 6;
#pragma unroll
        for (int m = 0; m < 8; ++m) {
            const int row = mt * 256 + wr * 128 + m * 16 + lr;
            f32x4 v[4];
#pragma unroll
            for (int n = 0; n < 4; ++n) v[n] = acc[m][n];
            if (kind == 5) {
                float s = 0.f;
#pragma unroll
                for (int n = 0; n < 4; ++n) s += (v[n][0] + v[n][1]) + (v[n][2] + v[n][3]);
                s += __shfl_xor(s, 16); s += __shfl_xor(s, 32);
                const float mu = s * (1.0f / 64.0f);
                float q = 0.f;
#pragma unroll
                for (int n = 0; n < 4; ++n) { v[n] = v[n] - mu; q += (v[n][0] * v[n][0] + v[n][1] * v[n][1]) + (v[n][2] * v[n][2] + v[n][3] * v[n][3]); }
                q += __shfl_xor(q, 16); q += __shfl_xor(q, 32);
                const float rs = rsqrtf(q * (1.0f / 64.0f) + EPS);
#pragma unroll
                for (int n = 0; n < 4; ++n) v[n] = v[n] * rs * *(const f32x4*)(p.g_idx_k + n * 16 + lq * 4);
            }
            if (kind == 2 || kind == 3 || kind == 5) {
#pragma unroll
                for (int jj = 0; jj < 4; ++jj) {
                    const float self = v[0][jj], other = __shfl_xor(self, 32);
                    const float2 cs = rope[(size_t)row * 8 + ((lq * 4 + jj) & 7)];
                    v[0][jj] = (lq < 2) ? (self * cs.x - other * cs.y) : (other * cs.y + self * cs.x);
                }
            }
            if (kind == 1 || kind == 3) {
#pragma unroll
                for (int n = 0; n < 4; ++n) v[n] = v[n] * 0.125f;
            }
            if (kind == 4) {
#pragma unroll
                for (int n = 0; n < 4; ++n)
#pragma unroll
                    for (int jj = 0; jj < 4; ++jj) v[n][jj] = sigmoidf_(v[n][jj]);
            }
            if (nt >= 16 && nt < 20) {
                const int head = (nt - 16) * 2 + wc;
                float am = 0.f;
#pragma unroll
                for (int n = 0; n < 4; ++n) am = fmaxf(fmaxf(am, fmaxf(fabsf(v[n][0]), fabsf(v[n][1]))), fmaxf(fabsf(v[n][2]), fabsf(v[n][3])));
                am = fmaxf(am, __shfl_xor(am, 16)); am = fmaxf(am, __shfl_xor(am, 32));
                const unsigned skb = pk2(am * (1.0f / 127.0f), 0.f) & 0xffffu;
                const float skf = bflo(skb), inv = skf > 0.f ? 1.0f / skf : 0.f;
                unsigned char* k8 = (unsigned char*)P + (size_t)row * (LDP * 2) + 4096 + head * 128;
#pragma unroll
                for (int n = 0; n < 4; ++n) {
                    int q4[4];
#pragma unroll
                    for (int jj = 0; jj < 4; ++jj) q4[jj] = (int)__builtin_rintf(fminf(fmaxf(v[n][jj] * inv, -127.f), 127.f));
                    const int w8 = (q4[0] & 0xff) | ((q4[1] & 0xff) << 8) | ((q4[2] & 0xff) << 16) | (q4[3] << 24);
                    *(int*)(k8 + (n * 2 + (lq >> 1)) * 16 + (lq & 1) * 4) = w8;
                }
                if (lq == 0) ((unsigned short*)(p.ws + WS_SKT))[head * S + row] = (unsigned short)skb;
            } else if (nt >= 20 && nt < 24) {
                const int isv = 1, head = (nt - 20) * 2 + wc;
                unsigned char* kv8 = (unsigned char*)P + (size_t)row * (LDP * 2) + 4096 + head * 128 + isv * 8;
#pragma unroll
                for (int n = 0; n < 4; ++n) {
                    f32x4 c = v[n] * 8.0f;
#pragma unroll
                    for (int jj = 0; jj < 4; ++jj) c[jj] = fminf(fmaxf(c[jj], -440.f), 440.f);
                    int w8 = __builtin_amdgcn_cvt_pk_fp8_f32(c[0], c[1], 0, false);
                    w8 = __builtin_amdgcn_cvt_pk_fp8_f32(c[2], c[3], w8, true);
                    *(int*)(kv8 + (n * 2 + (lq >> 1)) * 16 + (lq & 1) * 4) = w8;
                }
            } else if (kind == 6) {
                if (lq < 4) *(f32x4*)(AUX + (size_t)row * 32 + lq * 4) = v[0];
                if (lq < 2) *(f32x4*)(AUX + (size_t)row * 32 + 16 + lq * 4) = v[1] * (0.35355339059327379f * 0.125f);
            } else {
#pragma unroll
                for (int n = 0; n < 4; ++n) {
                    u32x2 w; w.x = pk2(v[n][0], v[n][1]); w.y = pk2(v[n][2], v[n][3]);
                    *(u32x2*)(P + (size_t)row * LDP + colw + n * 16 + lq * 4) = w;
                    if (kind == 5) *(u32x2*)(KI + ((size_t)((row >> 5) * 4 + n) * 64 + (lq >> 1) * 32 + (row & 31)) * 8 + (lq & 1) * 4) = w;
                }
            }
        }
    }
}

constexpr int GL_QT = 0, GL_KT = 8192, GL_VT = 16384, GL_ST = 32768, GL_AM = 49152, GL_TOT = 57344;
DEVI int el_off(int row, int col) { return tile_off(row, col >> 3) + (col & 7) * 2; }

template <bool G3>
static DEVI void gla_item(const Params& p, int item, unsigned char* lds, int tid) {
    const int n = item >> 2, h = item & 3, t0 = n * 64;
    const int lane = tid & 63, wave = __builtin_amdgcn_readfirstlane(tid >> 6), lr = lane & 15, lq = lane >> 4;
    bf16_t* P = (bf16_t*)(p.ws + WS_P);
    const float* AUX = (const float*)(p.ws + WS_AUX);
    float* U = (float*)((unsigned char*)p.out + DO_H);
    float* GD = (float*)((unsigned char*)p.out + DO_GD);
    float* TOT = (float*)(lds + GL_TOT);
    __syncthreads();
    {
        const int d = tid & 63, tq = tid >> 6, colh = h * 64 + d;
        float w2r[16];
#pragma unroll
        for (int r = 0; r < 16; ++r) w2r[r] = p.w_gla_a2[r * 256 + colh];
        const float bb = p.b_gla_a[colh];
        float bc[16]; float run = 0.f;
#pragma unroll
        for (int i = 0; i < 16; ++i) {
            const float* ga = AUX + (size_t)(t0 + tq * 16 + i) * 32;
            float z = bb;
#pragma unroll
            for (int r4 = 0; r4 < 4; ++r4) { const f32x4 g = *(const f32x4*)(ga + r4 * 4); z += g[0] * w2r[r4 * 4] + g[1] * w2r[r4 * 4 + 1] + g[2] * w2r[r4 * 4 + 2] + g[3] * w2r[r4 * 4 + 3]; }
            const float ls = fminf(z, 0.f) - __logf(1.0f + __expf(-fabsf(z)));
            run += ls * (1.0f / 16.0f); bc[i] = run;
        }
        TOT[tq * 64 + d] = run;
        __syncthreads();
        float off = 0.f, blast = 0.f;
#pragma unroll
        for (int q = 0; q < 4; ++q) { const float v = TOT[q * 64 + d]; blast += v; off += (q < tq) ? v : 0.f; }
#pragma unroll
        for (int i = 0; i < 16; ++i) {
            const int tl = tq * 16 + i; const size_t rowp = (size_t)(t0 + tl) * LDP;
            const float b = bc[i] + off;
            const float kv = bf2f(P[rowp + C_GK + colh]);
            if (G3) {
                const float qv = bf2f(P[rowp + C_GQ + colh]);
                *(bf16_t*)(lds + GL_QT + el_off(tl, d)) = (bf16_t)f2bf(qv * __expf(b));
                *(bf16_t*)(lds + GL_KT + el_off(tl, d)) = (bf16_t)f2bf(kv * __expf(-b));
            } else {
                *(bf16_t*)(lds + GL_KT + el_off(d, tl)) = (bf16_t)f2bf(kv * __expf(blast - b));
            }
        }
        if (!G3 && tq == 0) GD[(size_t)item * 64 + d] = __expf(blast);
    }
    {
        const int v0 = (tid & 15) * 8;
#pragma unroll
        for (int i = 0; i < 4; ++i) {
            const int s = (tid >> 4) + 16 * i;
            const u32x4 w = *(const u32x4*)(P + (size_t)(t0 + s) * LDP + C_GV + h * 128 + v0);
            const unsigned ww[4] = {w.x, w.y, w.z, w.w};
#pragma unroll
            for (int j = 0; j < 8; ++j) *(bf16_t*)(lds + GL_VT + el_off(v0 + j, s)) = (bf16_t)((ww[j >> 1] >> ((j & 1) * 16)) & 0xffffu);
        }
    }
    if (G3) {
        const int v = tid & 127, dg = tid >> 7;
        const float* Sn = U + (size_t)item * 8192;
#pragma unroll 8
        for (int i = 0; i < 32; ++i) { const int d = dg * 32 + i; *(bf16_t*)(lds + GL_ST + el_off(v, d)) = (bf16_t)f2bf(Sn[d * 128 + v]); }
    }
    __syncthreads();
    if (G3) {
        bf16x8 aq[2];
#pragma unroll
        for (int ks = 0; ks < 2; ++ks) aq[ks] = *(const bf16x8*)(lds + GL_QT + tile_off(wave * 16 + lr, ks * 4 + lq));
        const int tl = wave * 16 + lr;
#pragma unroll
        for (int nb = 0; nb < 4; ++nb) {
            f32x4 c = {0.f, 0.f, 0.f, 0.f};
#pragma unroll
            for (int ks = 0; ks < 2; ++ks) { const bf16x8 bk = *(const bf16x8*)(lds + GL_KT + tile_off(nb * 16 + lr, ks * 4 + lq)); c = __builtin_amdgcn_mfma_f32_16x16x32_bf16(bk, aq[ks], c, 0, 0, 0); }
#pragma unroll
            for (int j = 0; j < 4; ++j) c[j] = (nb * 16 + 4 * lq + j <= tl) ? c[j] : 0.f;
            u32x2 w; w.x = pk2(c[0], c[1]); w.y = pk2(c[2], c[3]);
            *(u32x2*)(lds + GL_AM + tile_off(tl, nb * 2 + (lq >> 1)) + (lq & 1) * 8) = w;
        }
        __syncthreads();
        bf16x8 am[2];
#pragma unroll
        for (int ks = 0; ks < 2; ++ks) am[ks] = *(const bf16x8*)(lds + GL_AM + tile_off(tl, ks * 4 + lq));
        f32x4 o[8]; float ss = 0.f;
#pragma unroll
        for (int vb = 0; vb < 8; ++vb) {
            f32x4 c = {0.f, 0.f, 0.f, 0.f};
#pragma unroll
            for (int ks = 0; ks < 2; ++ks) {
                const bf16x8 bs = *(const bf16x8*)(lds + GL_ST + tile_off(vb * 16 + lr, ks * 4 + lq));
                c = __builtin_amdgcn_mfma_f32_16x16x32_bf16(bs, aq[ks], c, 0, 0, 0);
                const bf16x8 bv = *(const bf16x8*)(lds + GL_VT + tile_off(vb * 16 + lr, ks * 4 + lq));
                c = __builtin_amdgcn_mfma_f32_16x16x32_bf16(bv, am[ks], c, 0, 0, 0);
            }
            o[vb] = c; ss += (c[0] * c[0] + c[1] * c[1]) + (c[2] * c[2] + c[3] * c[3]);
        }
        ss += __shfl_xor(ss, 16); ss += __shfl_xor(ss, 32);
        const float rstd = rsqrtf(ss * (1.0f / 128.0f) + EPS);
        const size_t rowp = (size_t)(t0 + tl) * LDP;
#pragma unroll
        for (int vb = 0; vb < 8; ++vb) {
            const int v0 = vb * 16 + 4 * lq;
            const u32x2 gg = *(const u32x2*)(P + rowp + C_GG + h * 128 + v0);
            const f32x4 g4 = *(const f32x4*)(p.g_gla_out + v0);
            const float y0 = o[vb][0] * rstd * g4[0] * siluf_(bflo(gg.x)), y1 = o[vb][1] * rstd * g4[1] * siluf_(bfhi(gg.x));
            const float y2 = o[vb][2] * rstd * g4[2] * siluf_(bflo(gg.y)), y3 = o[vb][3] * rstd * g4[3] * siluf_(bfhi(gg.y));
            u32x2 w; w.x = pk2(y0, y1); w.y = pk2(y2, y3);
            *(u32x2*)(P + rowp + C_OA + h * 128 + v0) = w;
        }
    } else {
        bf16x8 ak[2];
#pragma unroll
        for (int ks = 0; ks < 2; ++ks) ak[ks] = *(const bf16x8*)(lds + GL_KT + tile_off(wave * 16 + lr, ks * 4 + lq));
#pragma unroll
        for (int vb = 0; vb < 8; ++vb) {
            f32x4 c = {0.f, 0.f, 0.f, 0.f};
#pragma unroll
            for (int ks = 0; ks < 2; ++ks) { const bf16x8 bv = *(const bf16x8*)(lds + GL_VT + tile_off(vb * 16 + lr, ks * 4 + lq)); c = __builtin_amdgcn_mfma_f32_16x16x32_bf16(bv, ak[ks], c, 0, 0, 0); }
            *(f32x4*)(U + (size_t)item * 8192 + (wave * 16 + lr) * 128 + vb * 16 + 4 * lq) = c;
        }
    }
}

static DEVI void gla_scan(const Params& p, int tid) {
    float* U = (float*)((unsigned char*)p.out + DO_H);
    const float* GD = (const float*)((unsigned char*)p.out + DO_GD);
    for (int e = blockIdx.x * NT + tid; e < 32768; e += gridDim.x * NT) {
        const int hd = e >> 7;
        float st = 0.f;
        float u[32], g[32];
#pragma unroll
        for (int q = 0; q < 32; ++q) { u[q] = U[(size_t)q * 32768 + e]; g[q] = GD[(size_t)q * 256 + hd]; }
        for (int n0 = 0; n0 < 256; n0 += 32) {
            float un[32], gn[32];
            const int n1 = n0 + 32 < 256 ? n0 + 32 : n0;
#pragma unroll
            for (int q = 0; q < 32; ++q) { un[q] = U[(size_t)(n1 + q) * 32768 + e]; gn[q] = GD[(size_t)(n1 + q) * 256 + hd]; }
#pragma unroll
            for (int q = 0; q < 32; ++q) { U[(size_t)(n0 + q) * 32768 + e] = st; st = g[q] * st + u[q]; }
#pragma unroll
            for (int q = 0; q < 32; ++q) { u[q] = un[q]; g[q] = gn[q]; }
        }
    }
}

constexpr int TK_CAP = 512, TK_K = 256, TK_WBYTES = 16384;
DEVI unsigned fkey(float f) { const unsigned b = __float_as_uint(f); return b ^ ((unsigned)((int)b >> 31) | 0x80000000u); }
DEVI int lane_prefix(unsigned long long m) { return __builtin_amdgcn_mbcnt_hi((unsigned)(m >> 32), __builtin_amdgcn_mbcnt_lo((unsigned)m, 0)); }

DEVI unsigned topk_prune(unsigned* s, int n, unsigned lo, int slack, int lane, int& cnew) {
    unsigned u[8]; unsigned mx = 0u;
#pragma unroll
    for (int i = 0; i < 8; ++i) { const int pos = i * 64 + lane; const unsigned v = s[pos]; u[i] = (pos < n) ? v : 0u; mx = u[i] > mx ? u[i] : mx; }
    mx = __ockl_wfred_max_u32(mx);
    const int top = 31 - __builtin_clz(mx ^ lo);
    unsigned T = (top >= 31) ? 0u : (mx & ~((2u << top) - 1u));
    int cT = n;
    for (int bit = top; bit >= 0; --bit) {
        const unsigned trial = T | (1u << bit);
        unsigned long long bm[8];
#pragma unroll
        for (int i = 0; i < 8; ++i) bm[i] = __ballot(u[i] >= trial);
        int c = 0;
#pragma unroll
        for (int i = 0; i < 8; ++i) c += __builtin_popcountll(bm[i]);
        if (c >= TK_K) { T = trial; cT = c; if (c <= TK_K + slack) break; }
    }
    int nb = 0;
#pragma unroll
    for (int i = 0; i < 8; ++i) {
        const bool keep = u[i] >= T;
        const unsigned long long km = __ballot(keep);
        if (keep) s[nb + lane_prefix(km)] = u[i];
        nb += __builtin_popcountll(km);
    }
    cnew = cT;
    return T;
}

static DEVI void topk_phase(const Params& p, unsigned char* lds, int tid) {
    const int lane = tid & 63, wave = __builtin_amdgcn_readfirstlane(tid >> 6), gw = blockIdx.x * 4 + wave, nw = gridDim.x * 4;
    const int r = lane & 31, hh = lane >> 5;
    const bf16_t* P = (const bf16_t*)(p.ws + WS_P);
    const bf16_t* KI = (const bf16_t*)(p.ws + WS_KI);
    const float* AUX = (const float*)(p.ws + WS_AUX);
    unsigned short* SEL = (unsigned short*)(p.ws + WS_SEL);
    int* SELC = (int*)(p.ws + WS_SELC);
    unsigned* cb = (unsigned*)(lds + wave * TK_WBYTES);
    for (int item = gw; item < 2048; item += nw) {
        const int qb0 = 4 * item, qb1 = 4 * (4095 - item);
        bf16x8 a[2][4]; u32x4 wf[2][2];
#pragma unroll
        for (int rt = 0; rt < 2; ++rt) {
            const int qb = rt ? qb1 : qb0;
            const int qa = qb + ((r >> 2) & 1) + 2 * ((r >> 4) & 1), ha = (r & 3) + 4 * ((r >> 3) & 1);
#pragma unroll
            for (int s4 = 0; s4 < 4; ++s4) a[rt][s4] = *(const bf16x8*)(P + (size_t)qa * LDP + C_IQ + ha * 64 + 16 * s4 + 8 * hh);
#pragma unroll
            for (int s = 0; s < 2; ++s) {
                const f32x4 w0 = *(const f32x4*)(AUX + (size_t)(qb + hh + 2 * s) * 32 + 16), w1 = *(const f32x4*)(AUX + (size_t)(qb + hh + 2 * s) * 32 + 20);
                const bool mine = (r == 4 * hh + s);
                u32x4 f; f.x = pk2(w0[0], w0[1]); f.y = pk2(w0[2], w0[3]); f.z = pk2(w1[0], w1[1]); f.w = pk2(w1[2], w1[3]);
                wf[rt][s] = mine ? f : (u32x4){0u, 0u, 0u, 0u};
            }
        }
        int cnt[8]; unsigned thr[8];
#pragma unroll
        for (int q = 0; q < 8; ++q) { cnt[q] = 0; thr[q] = 0u; }
        const int ntile0 = (qb0 + 3) / 32 + 1, ntile = (qb1 + 3) / 32 + 1;
        const unsigned char* KIb = (const unsigned char*)KI;
        auto loadb = [&](bf16x8 (&b)[4], int kt) {
            const int kc = kt < ntile ? kt : ntile - 1;
            const unsigned off = (unsigned)kc * 4096u + (unsigned)lane * 16u;
#pragma unroll
            for (int s4 = 0; s4 < 4; ++s4) b[s4] = *(const bf16x8*)(KIb + (off + s4 * 1024u));
        };
        unsigned thv[2][2];
        auto refresh_thv = [&]() {
#pragma unroll
            for (int rt = 0; rt < 2; ++rt)
#pragma unroll
                for (int sel = 0; sel < 2; ++sel) thv[rt][sel] = hh ? thr[rt * 4 + 2 * sel + 1] : thr[rt * 4 + 2 * sel];
        };
        int cmax = 0;
        auto prune_while = [&](int limit, int slack) {
            if (cmax <= limit) return;
            for (;;) {
                int qi = -1;
#pragma unroll
                for (int q = 7; q >= 0; --q) qi = (cnt[q] > limit) ? q : qi;
                qi = __builtin_amdgcn_readfirstlane(qi);
                if (qi < 0) {
                    refresh_thv();
                    cmax = 0;
#pragma unroll
                    for (int q = 0; q < 8; ++q) cmax = cnt[q] > cmax ? cnt[q] : cmax;
                    break;
                }
                int nq = 0; unsigned lo = 0u;
#pragma unroll
                for (int q = 0; q < 8; ++q) { nq = (q == qi) ? cnt[q] : nq; lo = (q == qi) ? thr[q] : lo; }
                int cn;
                const unsigned T = topk_prune(cb + qi * TK_CAP, nq, lo, slack, lane, cn);
#pragma unroll
                for (int q = 0; q < 8; ++q) if (q == qi) { cnt[q] = __builtin_amdgcn_readfirstlane(cn); thr[q] = __builtin_amdgcn_readfirstlane(T); }
            }
        };
        refresh_thv();
        auto score_tile = [&](const f32x16& acc, int rt, int kt, bool masked) {
            const int key = kt * 32 + r, qb = rt ? qb1 : qb0;
            u32x4 x0, x1;
            x0.x = relu2_bf16(pk2(acc[0], acc[1])); x0.y = relu2_bf16(pk2(acc[2], acc[3])); x0.z = relu2_bf16(pk2(acc[4], acc[5])); x0.w = relu2_bf16(pk2(acc[6], acc[7]));
            x1.x = relu2_bf16(pk2(acc[8], acc[9])); x1.y = relu2_bf16(pk2(acc[10], acc[11])); x1.z = relu2_bf16(pk2(acc[12], acc[13])); x1.w = relu2_bf16(pk2(acc[14], acc[15]));
            f32x16 y;
#pragma unroll
            for (int q = 0; q < 16; ++q) y[q] = 0.f;
            y = __builtin_amdgcn_mfma_f32_32x32x16_bf16(__builtin_bit_cast(bf16x8, wf[rt][0]), __builtin_bit_cast(bf16x8, x0), y, 0, 0, 0);
            y = __builtin_amdgcn_mfma_f32_32x32x16_bf16(__builtin_bit_cast(bf16x8, wf[rt][1]), __builtin_bit_cast(bf16x8, x1), y, 0, 0, 0);
#pragma unroll
            for (int sel = 0; sel < 2; ++sel) {
                const float s = sel ? y[1] : y[0];
                const int ql = rt * 4 + 2 * sel, qh = ql + 1;
                const unsigned comp = (fkey(s) & 0xFFFFC000u) | (unsigned)(16383 - key);
                bool pass = comp > thv[rt][sel];
                if (masked) pass = pass && (key <= qb + 2 * sel + hh);
                const unsigned long long m = __ballot(pass);
                if (m) {
                    const unsigned lo = (unsigned)m, hi = (unsigned)(m >> 32);
                    const int nlo = __builtin_popcount(lo), nhi = __builtin_popcount(hi);
                    const int basev = hh ? (cnt[qh] - nlo) : cnt[ql];
                    const int pos = __builtin_amdgcn_mbcnt_hi(hi, __builtin_amdgcn_mbcnt_lo(lo, basev));
                    if (pass) cb[(ql + hh) * TK_CAP + pos] = comp;
                    cnt[ql] = __builtin_amdgcn_readfirstlane(cnt[ql] + nlo); cnt[qh] = __builtin_amdgcn_readfirstlane(cnt[qh] + nhi);
                    cmax = cnt[ql] > cmax ? cnt[ql] : cmax; cmax = cnt[qh] > cmax ? cnt[qh] : cmax;
                }
            }
        };
        auto step = [&](bf16x8 (&b)[4], int kt) {
            if (kt < ntile) {
                f32x16 acc1;
#pragma unroll
                for (int q = 0; q < 16; ++q) acc1[q] = 0.f;
#pragma unroll
                for (int s4 = 0; s4 < 4; ++s4) acc1 = __builtin_amdgcn_mfma_f32_32x32x16_bf16(a[1][s4], b[s4], acc1, 0, 0, 0);
                if (kt < ntile0) {
                    f32x16 acc0;
#pragma unroll
                    for (int q = 0; q < 16; ++q) acc0[q] = 0.f;
#pragma unroll
                    for (int s4 = 0; s4 < 4; ++s4) acc0 = __builtin_amdgcn_mfma_f32_32x32x16_bf16(a[0][s4], b[s4], acc0, 0, 0, 0);
                    if (kt == ntile0 - 1) score_tile(acc0, 0, kt, true); else score_tile(acc0, 0, kt, false);
                }
                if (kt == ntile - 1) score_tile(acc1, 1, kt, true); else score_tile(acc1, 1, kt, false);
                prune_while(TK_CAP - 32, 32);
            }
            loadb(b, kt + 6);
        };
        bf16x8 b0[4], b1[4], b2[4], b3[4], b4[4], b5[4];
        loadb(b0, 0); loadb(b1, 1); loadb(b2, 2); loadb(b3, 3); loadb(b4, 4); loadb(b5, 5);
        for (int kt = 0; kt < ntile; kt += 6) { step(b0, kt); step(b1, kt + 1); step(b2, kt + 2); step(b3, kt + 3); step(b4, kt + 4); step(b5, kt + 5); }
        cmax = TK_CAP; prune_while(TK_K, 0);
#pragma unroll
        for (int qi = 0; qi < 8; ++qi) {
            const int c = cnt[qi], qg = ((qi >> 2) ? qb1 : qb0) + (qi & 3);
#pragma unroll
            for (int i = 0; i < 4; ++i) { const int pos = i * 64 + lane; const unsigned v = cb[qi * TK_CAP + pos]; SEL[(size_t)qg * 256 + pos] = (pos < c) ? (unsigned short)(16383u - (v & 0x3FFFu)) : (unsigned short)0; }
            if (lane == 0) SELC[qg] = c;
        }
    }
}

typedef float f32x2d_t __attribute__((ext_vector_type(2)));
DEVI float dpp_f(float x, const int ctrl_sel) {
    const int xi = __builtin_bit_cast(int, x);
    const int y = (ctrl_sel == 0) ? __builtin_amdgcn_update_dpp(0, xi, 0xB1, 0xF, 0xF, true) : (ctrl_sel == 1) ? __builtin_amdgcn_update_dpp(0, xi, 0x4E, 0xF, 0xF, true)
                                                                                                              : __builtin_amdgcn_update_dpp(0, xi, 0x141, 0xF, 0xF, true);
    return __builtin_bit_cast(float, y);
}
DEVI float red8_max(float v) { v = fmaxf(v, dpp_f(v, 0)); v = fmaxf(v, dpp_f(v, 1)); v = fmaxf(v, dpp_f(v, 2)); return v; }
DEVI float red8_sum(float v) { v += dpp_f(v, 0); v += dpp_f(v, 1); v += dpp_f(v, 2); return v; }
DEVI int dpp_i(int x, const int ctrl_sel) {
    return (ctrl_sel == 0) ? __builtin_amdgcn_update_dpp(0, x, 0xB1, 0xF, 0xF, true) : (ctrl_sel == 1) ? __builtin_amdgcn_update_dpp(0, x, 0x4E, 0xF, 0xF, true) : __builtin_amdgcn_update_dpp(0, x, 0x141, 0xF, 0xF, true);
}
DEVI int xreduce8i(const int (&part)[8], int lane) {
    int r4[4], r2[2];
#pragma unroll
    for (int j = 0; j < 4; ++j) { const int mine = (lane & 4) ? part[j + 4] : part[j], send = (lane & 4) ? part[j] : part[j + 4]; r4[j] = mine + dpp_i(send, 2); }
#pragma unroll
    for (int j = 0; j < 2; ++j) { const int mine = (lane & 2) ? r4[j + 2] : r4[j], send = (lane & 2) ? r4[j] : r4[j + 2]; r2[j] = mine + dpp_i(send, 1); }
    const int mine = (lane & 1) ? r2[1] : r2[0], send = (lane & 1) ? r2[0] : r2[1];
    return mine + dpp_i(send, 0);
}
DEVI float xreduce8(const float (&part)[8], int lane) {
    float r4[4], r2[2];
#pragma unroll
    for (int j = 0; j < 4; ++j) { const float mine = (lane & 4) ? part[j + 4] : part[j], send = (lane & 4) ? part[j] : part[j + 4]; r4[j] = mine + dpp_f(send, 2); }
#pragma unroll
    for (int j = 0; j < 2; ++j) { const float mine = (lane & 2) ? r4[j + 2] : r4[j], send = (lane & 2) ? r4[j] : r4[j + 2]; r2[j] = mine + dpp_f(send, 1); }
    const float mine = (lane & 1) ? r2[1] : r2[0], send = (lane & 1) ? r2[0] : r2[1];
    return mine + dpp_f(send, 0);
}
template <bool LT>
static DEVI void sa_item(const Params& p, unsigned char* wl, const unsigned short* skl, int grp, int h, int lane) {
    const unsigned char* Pb = (const unsigned char*)(p.ws + WS_P);
    const unsigned short* SEL = (const unsigned short*)(p.ws + WS_SEL);
    const int* SELC = (const int*)(p.ws + WS_SELC);
    unsigned short* sI = (unsigned short*)wl;
    float* sP = (float*)(wl + 4096);
    const int qi = lane >> 3, d8 = lane & 7, t0 = grp * 8, t = t0 + qi;
    const int n = SELC[t], nlast = __builtin_amdgcn_readfirstlane(SELC[t0 + 7]);
    const int ng = (nlast + 7) >> 3;
#pragma unroll
    for (int i = 0; i < 4; ++i) *(u32x4*)(wl + i * 1024 + lane * 16) = *(const u32x4*)((const unsigned char*)(SEL + (size_t)t0 * 256) + i * 1024 + lane * 16);
    asm volatile("" ::: "memory");
    const u32x4 qv = *(const u32x4*)(Pb + (unsigned)t * (LDP * 2) + (C_DQ + h * 64 + d8 * 8) * 2);
    const float qf[8] = {bflo(qv.x), bfhi(qv.x), bflo(qv.y), bfhi(qv.y), bflo(qv.z), bfhi(qv.z), bflo(qv.w), bfhi(qv.w)};
    float qa = 0.f;
#pragma unroll
    for (int i = 0; i < 8; ++i) qa = fmaxf(qa, fabsf(qf[i]));
    qa = red8_max(qa);
    const float qinv = qa > 0.f ? 127.0f / qa : 0.f, qs = qa * (1.4426950408889634f / 127.0f);
    int qq[8];
#pragma unroll
    for (int i = 0; i < 8; ++i) qq[i] = (int)__builtin_rintf(qf[i] * qinv);
    const int q8a = (qq[0] & 0xff) | ((qq[1] & 0xff) << 8) | ((qq[2] & 0xff) << 16) | (qq[3] << 24), q8b = (qq[4] & 0xff) | ((qq[5] & 0xff) << 8) | ((qq[6] & 0xff) << 16) | (qq[7] << 24);
    const unsigned short* skg = (const unsigned short*)(p.ws + WS_SKT) + (size_t)h * S;
    const unsigned kvoff = 4096u + h * 128 + d8 * 16;
    float m = -__builtin_inff(), lsum = 0.f;
    f32x2d_t acc2[4] = {{0.f, 0.f}, {0.f, 0.f}, {0.f, 0.f}, {0.f, 0.f}};
    auto compute2 = [&](const u32x4 (&kv)[16], const unsigned (&sk)[2], int g) {
        int part[2][8];
#pragma unroll
        for (int j = 0; j < 16; ++j) part[j >> 3][j & 7] = __builtin_amdgcn_sdot4(q8b, (int)kv[j].y, __builtin_amdgcn_sdot4(q8a, (int)kv[j].x, 0, false), false);
        float s0 = (float)xreduce8i(part[0], lane) * (qs * bflo(sk[0])), s1 = (float)xreduce8i(part[1], lane) * (qs * bflo(sk[1]));
        s0 = (g * 8 + d8 < n) ? s0 : -__builtin_inff();
        s1 = (g * 8 + 8 + d8 < n) ? s1 : -__builtin_inff();
        const float mnew = fmaxf(m, red8_max(fmaxf(s0, s1)));
        const float sc = __builtin_amdgcn_exp2f(m - mnew), pm0 = __builtin_amdgcn_exp2f(s0 - mnew), pm1 = __builtin_amdgcn_exp2f(s1 - mnew);
        lsum = lsum * sc + red8_sum(pm0 + pm1);
        m = mnew;
        asm volatile("" ::: "memory");
        sP[lane] = pm0; sP[64 + lane] = pm1;
        asm volatile("" ::: "memory");
        const f32x4 p0 = *(const f32x4*)(sP + qi * 8), p1 = *(const f32x4*)(sP + qi * 8 + 4), p2 = *(const f32x4*)(sP + 64 + qi * 8), p3 = *(const f32x4*)(sP + 64 + qi * 8 + 4);
        asm volatile("" ::: "memory");
        const f32x2d_t sc2 = {sc, sc};
#pragma unroll
        for (int i = 0; i < 4; ++i) acc2[i] = acc2[i] * sc2;
#pragma unroll
        for (int j = 0; j < 16; ++j) {
            const float pj = (j < 4) ? p0[j & 3] : (j < 8) ? p1[j & 3] : (j < 12) ? p2[j & 3] : p3[j & 3];
            const f32x2d_t pj2 = {pj, pj};
            const int v0 = (int)kv[j].z, v1 = (int)kv[j].w;
            acc2[0] = pj2 * __builtin_amdgcn_cvt_pk_f32_fp8(v0, false) + acc2[0];
            acc2[1] = pj2 * __builtin_amdgcn_cvt_pk_f32_fp8(v0, true) + acc2[1];
            acc2[2] = pj2 * __builtin_amdgcn_cvt_pk_f32_fp8(v1, false) + acc2[2];
            acc2[3] = pj2 * __builtin_amdgcn_cvt_pk_f32_fp8(v1, true) + acc2[3];
        }
    };
    auto issue2 = [&](u32x4 (&dst)[16], unsigned (&sk)[2], int g) {
        const int ga = g < 31 ? g : 30;
        const unsigned ia = sI[qi * 256 + ga * 8 + d8], ib = sI[qi * 256 + ga * 8 + 8 + d8];
        sk[0] = LT ? skl[ia] : skg[ia]; sk[1] = LT ? skl[ib] : skg[ib];
        const u32x4 iw = *(const u32x4*)(sI + qi * 256 + ga * 8), ix = *(const u32x4*)(sI + qi * 256 + ga * 8 + 8);
        const unsigned id[16] = {iw.x & 0xffffu, iw.x >> 16, iw.y & 0xffffu, iw.y >> 16, iw.z & 0xffffu, iw.z >> 16, iw.w & 0xffffu, iw.w >> 16,
                                 ix.x & 0xffffu, ix.x >> 16, ix.y & 0xffffu, ix.y >> 16, ix.z & 0xffffu, ix.z >> 16, ix.w & 0xffffu, ix.w >> 16};
#pragma unroll
        for (int j = 0; j < 16; ++j) dst[j] = *(const u32x4*)(Pb + (id[j] * (unsigned)(LDP * 2) + kvoff));
    };
    u32x4 kvX[16], kvY[16]; unsigned skX[2], skY[2];
    issue2(kvX, skX, 0); issue2(kvY, skY, 2 < ng ? 2 : 0);
    for (int g = 0; g < ng; g += 4) {
        compute2(kvX, skX, g);
        issue2(kvX, skX, g + 4 < ng ? g + 4 : 0);
        if (g + 2 < ng) compute2(kvY, skY, g + 2);
        issue2(kvY, skY, g + 6 < ng ? g + 6 : 0);
    }
    const float inv = 0.125f / lsum;
    u32x4 w; w.x = pk2(acc2[0].x * inv, acc2[0].y * inv); w.y = pk2(acc2[1].x * inv, acc2[1].y * inv); w.z = pk2(acc2[2].x * inv, acc2[2].y * inv); w.w = pk2(acc2[3].x * inv, acc2[3].y * inv);
    *(u32x4*)(p.ws + WS_P + ((size_t)t * LDP + C_OB + h * 64 + d8 * 8) * 2) = w;
    asm volatile("" ::: "memory");
}
static DEVI void sa_phase(const Params& p, unsigned char* lds, int tid) {
    const int lane = tid & 63, wave = __builtin_amdgcn_readfirstlane(tid >> 6);
    unsigned char* wl = lds + wave * 4608;
    if ((gridDim.x & 7) == 0) {
        const int h = blockIdx.x & 7, lw = (blockIdx.x >> 3) * 4 + wave, nlw = (gridDim.x >> 3) * 4;
        unsigned short* skl = (unsigned short*)(lds + 20480);
        const unsigned char* skg = p.ws + WS_SKT + (size_t)h * S * 2;
#pragma unroll
        for (int i = 0; i < 8; ++i) *(u32x4*)((unsigned char*)skl + i * 4096 + tid * 16) = *(const u32x4*)(skg + i * 4096 + tid * 16);
        __syncthreads();
        for (int grp = lw; grp < S / 8; grp += nlw) sa_item<true>(p, wl, skl, grp, h, lane);
    } else {
        const int gw = blockIdx.x * 4 + wave, nw = gridDim.x * 4;
        for (int it = gw; it < S; it += nw) sa_item<false>(p, wl, nullptr, it >> 3, it & 7, lane);
    }
}

template <bool WITH_DSA>
static DEVI void phaseM1(const Params& p, unsigned char* lds, int tid) {
    const int lane = tid & 63, wave = __builtin_amdgcn_readfirstlane(tid >> 6), wr = wave >> 1, wc = wave & 1, lr = lane & 15, lq = lane >> 4;
    const bf16_t* P = (const bf16_t*)(p.ws + WS_P);
    const bf16_t* wpg = (const bf16_t*)((unsigned char*)p.out + DO_WPG);
    const bf16_t* wpd = (const bf16_t*)((unsigned char*)p.out + DO_WPD);
    bf16_t* mix = (bf16_t*)((unsigned char*)p.out + DO_H);
    for (int i = blockIdx.x; i < 1024; i += gridDim.x) {
        const int xcd = i & 7, j = i >> 3, nt = j & 7, mt = xcd * 16 + (j >> 3);
        f32x4 acc[4][4]; zero_acc(acc);
        {
            const bf16_t* ap[4]; const bf16_t* bp[4];
#pragma unroll
            for (int q = 0; q < 4; ++q) {
                ap[q] = P + (size_t)(mt * 128 + q * 32 + (tid >> 3)) * LDP + C_OA + gemm_kc(tid);
                bp[q] = wpg + (size_t)(nt * 128 + bperm(q * 32 + (tid >> 3))) * 512 + gemm_kc(tid);
            }
            gemm128(acc, ap, bp, 8, lds, tid);
        }
#pragma unroll
        for (int m = 0; m < 4; ++m) {
            const size_t rowp = (size_t)(mt * 128 + wr * 64 + m * 16 + lr) * LDP;
#pragma unroll
            for (int h2 = 0; h2 < 2; ++h2) {
                const u32x4 g = *(const u32x4*)(P + rowp + C_BG + nt * 128 + wc * 64 + lq * 16 + h2 * 8);
                acc[m][2 * h2][0] *= bflo(g.x); acc[m][2 * h2][1] *= bfhi(g.x); acc[m][2 * h2][2] *= bflo(g.y); acc[m][2 * h2][3] *= bfhi(g.y);
                acc[m][2 * h2 + 1][0] *= bflo(g.z); acc[m][2 * h2 + 1][1] *= bfhi(g.z); acc[m][2 * h2 + 1][2] *= bflo(g.w); acc[m][2 * h2 + 1][3] *= bfhi(g.w);
            }
        }
        if (WITH_DSA) {
            u32x2 park[4][4];
#pragma unroll
            for (int m = 0; m < 4; ++m)
#pragma unroll
                for (int n = 0; n < 4; ++n) { park[m][n].x = pk2(acc[m][n][0], acc[m][n][1]); park[m][n].y = pk2(acc[m][n][2], acc[m][n][3]); }
            zero_acc(acc);
            {
                const bf16_t* ap2[4]; const bf16_t* bp2[4];
#pragma unroll
                for (int q = 0; q < 4; ++q) {
                    ap2[q] = P + (size_t)(mt * 128 + q * 32 + (tid >> 3)) * LDP + C_OB + gemm_kc(tid);
                    bp2[q] = wpd + (size_t)(nt * 128 + bperm(q * 32 + (tid >> 3))) * 512 + gemm_kc(tid);
                }
                gemm128(acc, ap2, bp2, 8, lds, tid);
            }
#pragma unroll
            for (int m = 0; m < 4; ++m) {
                const size_t row = (size_t)(mt * 128 + wr * 64 + m * 16 + lr);
#pragma unroll
                for (int h2 = 0; h2 < 2; ++h2) {
                    const u32x4 g = *(const u32x4*)(P + row * LDP + C_BG + 1024 + nt * 128 + wc * 64 + lq * 16 + h2 * 8);
                    const u32x2 k0 = park[m][2 * h2], k1 = park[m][2 * h2 + 1];
                    acc[m][2 * h2][0] = acc[m][2 * h2][0] * bflo(g.x) + bflo(k0.x); acc[m][2 * h2][1] = acc[m][2 * h2][1] * bfhi(g.x) + bfhi(k0.x);
                    acc[m][2 * h2][2] = acc[m][2 * h2][2] * bflo(g.y) + bflo(k0.y); acc[m][2 * h2][3] = acc[m][2 * h2][3] * bfhi(g.y) + bfhi(k0.y);
                    acc[m][2 * h2 + 1][0] = acc[m][2 * h2 + 1][0] * bflo(g.z) + bflo(k1.x); acc[m][2 * h2 + 1][1] = acc[m][2 * h2 + 1][1] * bfhi(g.z) + bfhi(k1.x);
                    acc[m][2 * h2 + 1][2] = acc[m][2 * h2 + 1][2] * bflo(g.w) + bflo(k1.y); acc[m][2 * h2 + 1][3] = acc[m][2 * h2 + 1][3] * bfhi(g.w) + bfhi(k1.y);
                }
            }
        }
#pragma unroll
        for (int m = 0; m < 4; ++m) {
            const size_t row = (size_t)(mt * 128 + wr * 64 + m * 16 + lr);
#pragma unroll
            for (int h2 = 0; h2 < 2; ++h2) {
                u32x4 w; w.x = pk2(acc[m][2 * h2][0], acc[m][2 * h2][1]); w.y = pk2(acc[m][2 * h2][2], acc[m][2 * h2][3]); w.z = pk2(acc[m][2 * h2 + 1][0], acc[m][2 * h2 + 1][1]); w.w = pk2(acc[m][2 * h2 + 1][2], acc[m][2 * h2 + 1][3]);
                *(u32x4*)(mix + row * 1024 + nt * 128 + wc * 64 + lq * 16 + h2 * 8) = w;
            }
        }
    }
}

static DEVI void phaseM2(const Params& p, unsigned char* lds, int tid) {
    const int lane = tid & 63, wave = __builtin_amdgcn_readfirstlane(tid >> 6), wr = wave >> 1, wc = wave & 1, lr = lane & 15, lq = lane >> 4;
    bf16_t* P = (bf16_t*)(p.ws + WS_P);
    const bf16_t* wo = (const bf16_t*)((unsigned char*)p.out + DO_WOUT);
    const bf16_t* mix = (const bf16_t*)((unsigned char*)p.out + DO_H);
    for (int i = blockIdx.x; i < 1024; i += gridDim.x) {
        const int xcd = i & 7, j = i >> 3, nt = j & 7, mt = xcd * 16 + (j >> 3);
        const bf16_t* ap[4]; const bf16_t* bp[4];
#pragma unroll
        for (int q = 0; q < 4; ++q) {
            ap[q] = mix + (size_t)(mt * 128 + q * 32 + (tid >> 3)) * 1024 + gemm_kc(tid);
            bp[q] = wo + (size_t)(nt * 128 + bperm(q * 32 + (tid >> 3))) * 1024 + gemm_kc(tid);
        }
        f32x4 acc[4][4]; zero_acc(acc);
        gemm128(acc, ap, bp, 16, lds, tid);
#pragma unroll
        for (int m = 0; m < 4; ++m) {
            bf16_t* orow = P + (size_t)(mt * 128 + wr * 64 + m * 16 + lr) * LDP;
#pragma unroll
            for (int h2 = 0; h2 < 2; ++h2) {
                u32x4 w; w.x = pk2(acc[m][2 * h2][0], acc[m][2 * h2][1]); w.y = pk2(acc[m][2 * h2][2], acc[m][2 * h2][3]); w.z = pk2(acc[m][2 * h2 + 1][0], acc[m][2 * h2 + 1][1]); w.w = pk2(acc[m][2 * h2 + 1][2], acc[m][2 * h2 + 1][3]);
                *(u32x4*)(orow + nt * 128 + wc * 64 + lq * 16 + h2 * 8) = w;
            }
        }
    }
}

static DEVI void phaseM3(const Params& p, unsigned char* lds, int tid) {
    const int lane = tid & 63, wave = __builtin_amdgcn_readfirstlane(tid >> 6);
    const float* mod = (const float*)(p.ws + WS_MOD);
    const bf16_t* WrTb = (const bf16_t*)(p.ws + WS_WRT);
    bf16_t* P = (bf16_t*)(p.ws + WS_P);
    int* LIST = (int*)(p.ws + WS_LIST);
    float* CW = (float*)(p.ws + WS_CW);
    int* cnt = (int*)(p.ws + WS_CNT);
    unsigned char* HT = lds;
    float* PART = (float*)(lds + 32768);
    float* LG = (float*)(lds + 32768 + 9216);
    float* BIAS = LG + 16 * 48;
    float* A2S = BIAS + 64;
    float* B2S = A2S + 1024;
    if (tid < 36) BIAS[tid] = tid < 4 ? p.b_rg[tid] : p.b_re[tid - 4];
    *(f32x4*)(A2S + tid * 4) = *(const f32x4*)(p.g_pre_ffn + tid * 4) * (*(const f32x4*)(mod + 4096 + tid * 4) + 1.0f);
    *(f32x4*)(B2S + tid * 4) = *(const f32x4*)(mod + 3072 + tid * 4);
    const int lr = lane & 15, lq = lane >> 4;
    bf16x8 wf[8][3];
#pragma unroll
    for (int s = 0; s < 8; ++s)
#pragma unroll
        for (int c = 0; c < 3; ++c) wf[s][c] = *(const bf16x8*)(WrTb + (size_t)(c * 16 + lr) * 1024 + wave * 256 + s * 32 + lq * 8);
    f32x4 G1[4];
#pragma unroll
    for (int i = 0; i < 4; ++i) {
        const int c0 = i * 256 + lane * 4;
        G1[i] = *(const f32x4*)(mod + 2048 + c0) * *(const f32x4*)(p.g_post_mix + c0);
    }
    for (int it = blockIdx.x; it < S / 16; it += gridDim.x) {
        __syncthreads();
#pragma unroll 1
        for (int rp = 0; rp < 2; ++rp) {
            u32x2 ob[2][4]; f32x4 xv[2][4]; float ss[2] = {0.f, 0.f};
#pragma unroll
            for (int q = 0; q < 2; ++q) {
                const size_t r = (size_t)it * 16 + wave * 4 + rp * 2 + q;
                const bf16_t* orow = P + r * LDP;
#pragma unroll
                for (int i = 0; i < 4; ++i) {
                    ob[q][i] = *(const u32x2*)(orow + i * 256 + lane * 4);
                    xv[q][i] = *(const f32x4*)(p.x + r * D + i * 256 + lane * 4);
                }
            }
#pragma unroll
            for (int q = 0; q < 2; ++q) {
#pragma unroll
                for (int i = 0; i < 4; ++i) { const float o0 = bflo(ob[q][i].x), o1 = bfhi(ob[q][i].x), o2 = bflo(ob[q][i].y), o3 = bfhi(ob[q][i].y); ss[q] += (o0 * o0 + o1 * o1) + (o2 * o2 + o3 * o3); }
                ss[q] = wave_sum(ss[q]);
            }
#pragma unroll
            for (int q = 0; q < 2; ++q) {
                const int rloc = wave * 4 + rp * 2 + q; const size_t r = (size_t)it * 16 + rloc;
                const float rstd1 = rsqrtf(ss[q] * (1.0f / 1024.0f) + EPS);
                float s2 = 0.f;
#pragma unroll
                for (int i = 0; i < 4; ++i) {
                    const int c0 = i * 256 + lane * 4;
                    const f32x4 ov = {bflo(ob[q][i].x), bfhi(ob[q][i].x), bflo(ob[q][i].y), bfhi(ob[q][i].y)};
                    xv[q][i] = xv[q][i] + G1[i] * ov * rstd1;
                    { u32x2 wm; wm.x = pk2(xv[q][i][0], xv[q][i][1]); wm.y = pk2(xv[q][i][2], xv[q][i][3]); *(u32x2*)(P + r * LDP + C_XM + c0) = wm; }
                    s2 += (xv[q][i][0] * xv[q][i][0] + xv[q][i][1] * xv[q][i][1]) + (xv[q][i][2] * xv[q][i][2] + xv[q][i][3] * xv[q][i][3]); }
                s2 = wave_sum(s2);
                const float rstd2 = rsqrtf(s2 * (1.0f / 1024.0f) + EPS);
#pragma unroll
                for (int i = 0; i < 4; ++i) {
                    const int c0 = i * 256 + lane * 4;
                    const f32x4 y = xv[q][i] * rstd2 * *(const f32x4*)(A2S + c0) + *(const f32x4*)(B2S + c0);
                    u32x2 w; w.x = pk2(y[0], y[1]); w.y = pk2(y[2], y[3]);
                    *(u32x2*)(P + r * LDP + C_H2 + c0) = w;
                    *(u32x2*)(HT + rloc * 2048 + (((c0 >> 3) ^ (rloc & 7)) << 4) + (c0 & 7) * 2) = w;
                }
            }
        }
        __syncthreads();
        f32x4 acc[3];
#pragma unroll
        for (int c = 0; c < 3; ++c) acc[c] = (f32x4){0.f, 0.f, 0.f, 0.f};
#pragma unroll
        for (int s = 0; s < 8; ++s) {
            const bf16x8 av = *(const bf16x8*)(HT + lr * 2048 + (((wave * 32 + s * 4 + lq) ^ (lr & 7)) << 4));
#pragma unroll
            for (int c = 0; c < 3; ++c) acc[c] = __builtin_amdgcn_mfma_f32_16x16x32_bf16(wf[s][c], av, acc[c], 0, 0, 0);
        }
        if (wave > 0) {
#pragma unroll
            for (int c = 0; c < 3; ++c) *(f32x4*)(PART + ((wave - 1) * 3 + c) * 256 + lane * 4) = acc[c];
        }
        __syncthreads();
        if (wave == 0) {
#pragma unroll
            for (int c = 0; c < 3; ++c) {
                f32x4 t = acc[c];
#pragma unroll
                for (int w = 0; w < 3; ++w) t = t + *(const f32x4*)(PART + (w * 3 + c) * 256 + lane * 4);
                *(f32x4*)(LG + lr * 48 + c * 16 + lq * 4) = t;
            }
            asm volatile("" ::: "memory");
            if (lane < 16) {
                const int t = it * 16 + lane;
                const float* lg = LG + lane * 48;
                float gl[4];
#pragma unroll
                for (int q = 0; q < 4; ++q) gl[q] = lg[q] + BIAS[q];
                int gs = 0; float gm = gl[0];
#pragma unroll
                for (int q = 1; q < 4; ++q) if (gl[q] > gm) { gm = gl[q]; gs = q; }
                float gsum = 0.f;
#pragma unroll
                for (int q = 0; q < 4; ++q) gsum += __expf(gl[q] - gm);
                const float pg = 1.0f / gsum;
                float el[8];
#pragma unroll
                for (int q = 0; q < 8; ++q) el[q] = lg[4 + gs * 8 + q] + BIAS[4 + gs * 8 + q];
                int i0 = 0; float m0 = el[0];
#pragma unroll
                for (int q = 1; q < 8; ++q) if (el[q] > m0) { m0 = el[q]; i0 = q; }
                int i1 = 0; float m1 = -3.0e38f;
#pragma unroll
                for (int q = 0; q < 8; ++q) if (q != i0 && el[q] > m1) { m1 = el[q]; i1 = q; }
                const float e1 = __expf(m1 - m0);
                const float w0 = pg / (1.0f + e1), w1 = pg * e1 / (1.0f + e1);
                const int ea = gs * 8 + i0, eb = gs * 8 + i1;
                const int sa = atomicAdd(&cnt[ea * 32], 1), sb = atomicAdd(&cnt[eb * 32], 1);
                CW[t * 2] = w0; CW[t * 2 + 1] = w1;
                LIST[(size_t)ea * S + sa] = t * 2; LIST[(size_t)eb * S + sb] = t * 2 + 1;
            }
        }
    }
}

DEVI bool moe_find_tile(const int* cl, int tile, int& e, int& j, int& base, int& ne) {
    int acc_t = 0, acc_r = 0; bool found = false; e = 0; j = 0; base = 0; ne = 0;
#pragma unroll 8
    for (int q = 0; q < NEXP; ++q) {
        const int c = cl[q], tq = (c + 127) >> 7;
        if (!found && tile < acc_t + tq) { found = true; e = q; j = tile - acc_t; base = acc_r; ne = c; }
        acc_t += tq; acc_r += c;
    }
    return found;
}
DEVI const int* moe_stage_counts(const Params& p, unsigned char* lds, int tid) {
    int* cl = (int*)(lds + 65536);
    __syncthreads();
    if (tid < NEXP) cl[tid] = ((const int*)(p.ws + WS_CNT))[tid * 32];
    __syncthreads();
    return cl;
}

static DEVI void phaseE1(const Params& p, unsigned char* lds, int tid) {
    const int lane = tid & 63, wave = __builtin_amdgcn_readfirstlane(tid >> 6), wr = wave >> 1, wc = wave & 1, lr = lane & 15, lq = lane >> 4;
    const bf16_t* P = (const bf16_t*)(p.ws + WS_P);
    const int* LIST = (const int*)(p.ws + WS_LIST);
    const float* CW = (const float*)(p.ws + WS_CW);
    const int* cnt = moe_stage_counts(p, lds, tid);
    bf16_t* ACT = (bf16_t*)(p.ws + WS_SEL);
    for (int it = blockIdx.x;; it += gridDim.x) {
        int e, j, base, ne;
        const bool ok = moe_find_tile(cnt, it >> 2, e, j, base, ne);
        if (!ok) break;
        const int nt = it & 3;
        const bf16_t* wgu = (const bf16_t*)(p.ws + WS_WGU) + (size_t)e * 512 * 1024;
        const bf16_t* ap[4]; const bf16_t* bp[4];
#pragma unroll
        for (int q = 0; q < 4; ++q) {
            int slot = j * 128 + q * 32 + (tid >> 3); slot = slot < ne ? slot : 0;
            const int tok = LIST[(size_t)e * S + slot] >> 1;
            ap[q] = P + (size_t)tok * LDP + C_H2 + gemm_kc(tid);
            bp[q] = wgu + (size_t)(nt * 128 + q * 32 + (tid >> 3)) * 1024 + gemm_kc(tid);
        }
        float cwm[4];
#pragma unroll
        for (int m = 0; m < 4; ++m) { const int slot = j * 128 + wr * 64 + m * 16 + lr; cwm[m] = CW[LIST[(size_t)e * S + (slot < ne ? slot : 0)]]; }
        f32x4 acc[4][4]; zero_acc(acc);
        gemm128(acc, ap, bp, 16, lds, tid);
#pragma unroll
        for (int m = 0; m < 4; ++m) {
            const int slot = j * 128 + wr * 64 + m * 16 + lr;
            if (slot < ne) {
                const float cw = cwm[m];
#pragma unroll
                for (int hp = 0; hp < 2; ++hp) {
                    const f32x4 g = acc[m][hp * 2], u = acc[m][hp * 2 + 1];
                    u32x2 w; w.x = pk2(siluf_(g[0]) * u[0] * cw, siluf_(g[1]) * u[1] * cw); w.y = pk2(siluf_(g[2]) * u[2] * cw, siluf_(g[3]) * u[3] * cw);
                    __hip_atomic_store((unsigned long long*)(ACT + (size_t)(base + slot) * 256 + nt * 64 + wc * 32 + hp * 16 + lq * 4), ((unsigned long long)w.y << 32) | w.x, __ATOMIC_RELAXED, __HIP_MEMORY_SCOPE_AGENT);
                }
            }
        }
        asm volatile("s_waitcnt vmcnt(0)" ::: "memory");
        __syncthreads();
        if (tid == 0) __hip_atomic_fetch_add((unsigned*)(p.ws + WS_CNT) + 1024 + (it >> 2), 1u, __ATOMIC_RELAXED, __HIP_MEMORY_SCOPE_AGENT);
    }
}

static DEVI void phaseE2(const Params& p, unsigned char* lds, int tid) {
    const int lane = tid & 63, wave = __builtin_amdgcn_readfirstlane(tid >> 6), wr = wave >> 1, wc = wave & 1, lr = lane & 15, lq = lane >> 4;
    bf16_t* P = (bf16_t*)(p.ws + WS_P);
    const int* LIST = (const int*)(p.ws + WS_LIST);
    const int* cnt = (const int*)(lds + 65536);
    const bf16_t* ACT = (const bf16_t*)(p.ws + WS_SEL);
    unsigned* queue = (unsigned*)(p.ws + WS_CNT) + 2;
    volatile int* qslot = (volatile int*)(lds + 65536 + 256);
    __syncthreads();
    if (tid == 0) *qslot = (int)__hip_atomic_fetch_add(queue, 1u, __ATOMIC_RELAXED, __HIP_MEMORY_SCOPE_AGENT);
    __syncthreads();
    int it = *qslot;
    for (;;) {
        int e, j, base, ne;
        const bool ok = moe_find_tile(cnt, it >> 3, e, j, base, ne);
        if (!ok) break;
        unsigned nxt = 0;
        if (tid == 0) {
            nxt = __hip_atomic_fetch_add(queue, 1u, __ATOMIC_RELAXED, __HIP_MEMORY_SCOPE_AGENT);
            while (__hip_atomic_load((unsigned*)(p.ws + WS_CNT) + 1024 + (it >> 3), __ATOMIC_RELAXED, __HIP_MEMORY_SCOPE_AGENT) < 4u) __builtin_amdgcn_s_sleep(2);
            __builtin_amdgcn_fence(__ATOMIC_ACQUIRE, "agent");
        }
        __syncthreads();
        const int nt = it & 7;
        const bf16_t* wd = (const bf16_t*)(p.ws + WS_WD) + (size_t)e * 1024 * 256;
        const bf16_t* ap[4]; const bf16_t* bp[4];
#pragma unroll
        for (int q = 0; q < 4; ++q) {
            int slot = j * 128 + q * 32 + (tid >> 3); slot = slot < ne ? slot : 0;
            ap[q] = ACT + (size_t)(base + slot) * 256 + gemm_kc(tid);
            bp[q] = wd + (size_t)(nt * 128 + bperm(q * 32 + (tid >> 3))) * 256 + gemm_kc(tid);
        }
        int entm[4];
#pragma unroll
        for (int m = 0; m < 4; ++m) { const int slot = j * 128 + wr * 64 + m * 16 + lr; entm[m] = LIST[(size_t)e * S + (slot < ne ? slot : 0)]; }
        f32x4 acc[4][4]; zero_acc(acc);
        gemm128(acc, ap, bp, 4, lds, tid);
#pragma unroll
        for (int m = 0; m < 4; ++m) {
            const int slot = j * 128 + wr * 64 + m * 16 + lr;
            if (slot < ne) {
                const int ent = entm[m];
                bf16_t* yrow = P + (size_t)(ent >> 1) * LDP + C_Y + (ent & 1) * 1024;
#pragma unroll
                for (int h2 = 0; h2 < 2; ++h2) {
                    u32x4 w; w.x = pk2(acc[m][2 * h2][0], acc[m][2 * h2][1]); w.y = pk2(acc[m][2 * h2][2], acc[m][2 * h2][3]); w.z = pk2(acc[m][2 * h2 + 1][0], acc[m][2 * h2 + 1][1]); w.w = pk2(acc[m][2 * h2 + 1][2], acc[m][2 * h2 + 1][3]);
                    *(u32x4*)(yrow + nt * 128 + wc * 64 + lq * 16 + h2 * 8) = w;
                }
            }
        }
        if (tid == 0) *qslot = (int)nxt;
        __syncthreads();
        it = *qslot;
    }
}

static DEVI void phaseF(const Params& p, int tid) {
    const int lane = tid & 63, gw = blockIdx.x * 4 + __builtin_amdgcn_readfirstlane(tid >> 6), nw = gridDim.x * 4;
    const float* mod = (const float*)(p.ws + WS_MOD);
    const bf16_t* P = (const bf16_t*)(p.ws + WS_P);
    f32x4 G[4];
#pragma unroll
    for (int i = 0; i < 4; ++i) { const int c0 = i * 256 + lane * 4; G[i] = *(const f32x4*)(mod + 5120 + c0) * *(const f32x4*)(p.g_post_ffn + c0); }
    for (int r0 = gw; r0 < S; r0 += 2 * nw) {
        f32x4 y[2][4], xm[2][4]; float ss[2] = {0.f, 0.f};
#pragma unroll
        for (int q = 0; q < 2; ++q) {
            const int r = (r0 + q * nw < S) ? r0 + q * nw : r0;
#pragma unroll
            for (int i = 0; i < 4; ++i) {
                const u32x2 a = *(const u32x2*)(P + (size_t)r * LDP + C_Y + i * 256 + lane * 4), b = *(const u32x2*)(P + (size_t)r * LDP + C_Y + 1024 + i * 256 + lane * 4);
                const u32x2 xb = *(const u32x2*)(P + (size_t)r * LDP + C_XM + i * 256 + lane * 4);
                xm[q][i] = (f32x4){bflo(xb.x), bfhi(xb.x), bflo(xb.y), bfhi(xb.y)};
                y[q][i][0] = bflo(a.x) + bflo(b.x); y[q][i][1] = bfhi(a.x) + bfhi(b.x); y[q][i][2] = bflo(a.y) + bflo(b.y); y[q][i][3] = bfhi(a.y) + bfhi(b.y);
            }
        }
#pragma unroll
        for (int q = 0; q < 2; ++q) {
#pragma unroll
            for (int i = 0; i < 4; ++i) ss[q] += (y[q][i][0] * y[q][i][0] + y[q][i][1] * y[q][i][1]) + (y[q][i][2] * y[q][i][2] + y[q][i][3] * y[q][i][3]);
            ss[q] = wave_sum(ss[q]);
        }
#pragma unroll
        for (int q = 0; q < 2; ++q) {
            const int r = r0 + q * nw;
            if (r < S) {
                const float rstd = rsqrtf(ss[q] * (1.0f / 1024.0f) + EPS);
#pragma unroll
                for (int i = 0; i < 4; ++i) *(f32x4*)(p.out + (size_t)r * D + i * 256 + lane * 4) = xm[q][i] + G[i] * y[q][i] * rstd;
            }
        }
    }
}

#ifndef STOP_AFTER_MIXER
#define STOP_AFTER_MIXER 0
#endif
__global__ void __launch_bounds__(NT, 2) mega(Params p) {
    __shared__ __attribute__((aligned(16))) unsigned char lds[LDS_BYTES];
    cg::grid_group grid = cg::this_grid();
    int tid = threadIdx.x;
    const int wv64 = __builtin_amdgcn_readfirstlane(tid & ~63);
#define FRESH_TID() do { int l_; asm volatile("v_mbcnt_lo_u32_b32 %0, -1, 0\n\tv_mbcnt_hi_u32_b32 %0, -1, %0" : "=v"(l_)); tid = wv64 + l_; } while (0)
    uint4* xb_words = (uint4*)(lds + LDS_BYTES - 16);
    if (tid == 0) *xb_words = make_uint4(0u, 0u, 0u, 0u);
    __syncthreads();
    if (p.out == nullptr) grid.sync();
    XcdBarrier xb = xcd_barrier_post((unsigned*)(p.ws + WS_BAR), (volatile LAS unsigned*)xb_words);
    FRESH_TID();
    phase0(p, lds, tid);
    FRESH_TID();
    phase1(p, tid);
    xcd_barrier(xb);
    FRESH_TID();
    phase2(p, lds, tid);
    xcd_barrier(xb);
    FRESH_TID();
    for (int it = blockIdx.x; it < 1024; it += gridDim.x) gla_item<false>(p, it, lds, tid);
    __syncthreads();
    FRESH_TID();
    topk_phase(p, lds, tid);
    xcd_barrier(xb);
    FRESH_TID();
    gla_scan(p, tid);
    xcd_barrier(xb);
    FRESH_TID();
    for (int it = blockIdx.x; it < 1024; it += gridDim.x) gla_item<true>(p, it, lds, tid);
    __syncthreads();
    FRESH_TID();
    sa_phase(p, lds, tid);
    xcd_barrier(xb);
    FRESH_TID();
    phaseM1<true>(p, lds, tid);
    xcd_barrier(xb);
    FRESH_TID();
    phaseM2(p, lds, tid);
    xcd_barrier(xb);
    FRESH_TID();
    phaseM3(p, lds, tid);
    xcd_barrier(xb);
    FRESH_TID();
    phaseE1(p, lds, tid);
    FRESH_TID();
    phaseE2(p, lds, tid);
    xcd_barrier(xb);
    FRESH_TID();
    phaseF(p, tid);
}

extern "C" void kernel_launch(void* const* d_in, const int* in_sizes, int n_in, void* d_out, int out_size, void* d_ws, size_t ws_size, hipStream_t stream) {
    static int grid_blocks = 0;
    if (!grid_blocks) {
        int dev = 0, cus = 0, per_cu = 0;
        hipGetDevice(&dev);
        hipDeviceGetAttribute(&cus, hipDeviceAttributeMultiprocessorCount, dev);
        hipOccupancyMaxActiveBlocksPerMultiprocessor(&per_cu, mega, NT, 0);
        if (per_cu > 2) per_cu = 2;
        if (per_cu < 1) per_cu = 1;
        grid_blocks = cus * per_cu;
        if (ws_size < WS_END) fprintf(stderr, "kernel_launch: workspace too small: %zu < %zu\n", ws_size, (size_t)WS_END);
    }
    Params p{};
    p.x = (const float*)d_in[0]; p.c = (const float*)d_in[1]; p.pos = (const int*)d_in[2]; p.w_ada = (const float*)d_in[3]; p.b_ada = (const float*)d_in[4];
    p.g_pre_mix = (const float*)d_in[5]; p.g_post_mix = (const float*)d_in[6]; p.g_pre_ffn = (const float*)d_in[7]; p.g_post_ffn = (const float*)d_in[8];
    p.w_in = (const float*)d_in[9]; p.w_gla_a2 = (const float*)d_in[10]; p.b_gla_a = (const float*)d_in[11]; p.g_gla_out = (const float*)d_in[12]; p.g_idx_k = (const float*)d_in[13];
    p.w_proj_gla = (const float*)d_in[14]; p.w_proj_dsa = (const float*)d_in[15]; p.w_out = (const float*)d_in[16];
    p.w_rg = (const float*)d_in[17]; p.b_rg = (const float*)d_in[18]; p.w_re = (const float*)d_in[19]; p.b_re = (const float*)d_in[20];
    p.w_eg = (const float*)d_in[21]; p.w_eu = (const float*)d_in[22]; p.w_ed = (const float*)d_in[23];
    p.out = (float*)d_out; p.ws = (unsigned char*)d_ws;
    (void)hipMemsetAsync((unsigned char*)d_ws + WS_CNT, 0, 8192 + XCD_BAR_WORDS * 4, stream);
    void* args[] = {&p};
    hipError_t e = hipLaunchCooperativeKernel((void*)mega, dim3(grid_blocks), dim3(NT), args, 0, stream);
    if (e != hipSuccess) fprintf(stderr, "cooperative launch failed: %s (grid %d)\n", hipGetErrorString(e), grid_blocks);
}
```

```cpp
#include <hip/hip_runtime.h>
#include <hip/hip_cooperative_groups.h>
#include <cstdio>
#include <cstdint>
namespace cg = cooperative_groups;

#define DEVI __device__ __forceinline__
typedef unsigned short bf16_t;
typedef short bf16x8 __attribute__((ext_vector_type(8)));
typedef float f32x4 __attribute__((ext_vector_type(4)));
typedef float f32x16 __attribute__((ext_vector_type(16)));
typedef unsigned u32x4 __attribute__((ext_vector_type(4)));
typedef unsigned u32x2 __attribute__((ext_vector_type(2)));
typedef int i32x8 __attribute__((ext_vector_type(8)));

constexpr int S = 16384, D = 1024, DIN = 5720;
constexpr int LDP = 5760;
constexpr int C_GQ = 0, C_GK = 256, C_GV = 512, C_GG = 1024, C_DQ = 1536, C_DK = 2048, C_DV = 2560, C_IQ = 3072, C_BG = 3584, C_IK = 5632, C_GA = 5696, C_IW = 5712;
constexpr int C_OA = C_GG, C_OB = C_DQ;
constexpr int B_OA8 = C_DV * 2, B_OB8 = C_DV * 2 + 512;
constexpr int C_XM = 1024;
constexpr int C_H2 = 2048;
constexpr int C_Y = 3072;
constexpr float EPS = 1e-6f;
constexpr int NEXP = 32, DEXP = 256;

constexpr size_t WS_P    = 0;
constexpr size_t WS_WGU  = WS_P + (size_t)S * LDP * 2;
constexpr size_t WS_H8   = WS_WGU + (size_t)NEXP * 512 * 1024;
constexpr size_t WS_WD   = WS_WGU + (size_t)NEXP * 512 * 1024 * 2;
constexpr size_t WS_SEL  = WS_WD + (size_t)NEXP * 1024 * 256 * 2;
constexpr size_t WS_KI   = WS_SEL + (size_t)16 * 1024 * 1024;
constexpr size_t WS_AUX  = WS_KI + (size_t)S * 64 * 2;
constexpr size_t WS_ROPE = WS_AUX + (size_t)S * 32 * 4;
constexpr size_t WS_LIST = WS_ROPE + (size_t)S * 8 * 8;
constexpr size_t WS_MOD  = WS_LIST + (size_t)NEXP * S * 4;
constexpr size_t WS_SELC = WS_MOD + 6144 * 4;
constexpr size_t WS_CW   = WS_SELC + (size_t)S * 4;
constexpr size_t WS_CNT  = WS_CW + (size_t)S * 2 * 4;
constexpr size_t WS_BAR  = WS_CNT + 8192;
constexpr size_t WS_WRT  = WS_BAR + 3456 * 4;
constexpr size_t WS_SKT  = WS_WRT + 48 * 1024 * 4;
constexpr size_t WS_END  = WS_SKT + (size_t)8 * S * 2;
constexpr size_t DO_H    = 0;
constexpr size_t DO_WIN  = (size_t)32 * 1024 * 1024;
constexpr size_t DO_WPG  = (size_t)44 * 1024 * 1024;
constexpr size_t DO_WPD  = (size_t)45 * 1024 * 1024;
constexpr size_t DO_WOUT = (size_t)46 * 1024 * 1024;
constexpr size_t DO_WG8  = (size_t)47 * 1024 * 1024;
constexpr size_t DO_GD   = (size_t)52 * 1024 * 1024;

constexpr int NT = 256;
constexpr int LDS_BYTES = 77824;

struct Params {
    const float* x; const float* c; const int* pos; const float* w_ada; const float* b_ada;
    const float* g_pre_mix; const float* g_post_mix; const float* g_pre_ffn; const float* g_post_ffn;
    const float* w_in; const float* w_gla_a2; const float* b_gla_a; const float* g_gla_out; const float* g_idx_k;
    const float* w_proj_gla; const float* w_proj_dsa; const float* w_out;
    const float* w_rg; const float* b_rg; const float* w_re; const float* b_re;
    const float* w_eg; const float* w_eu; const float* w_ed;
    float* out; unsigned char* ws;
};

typedef __bf16 bf16v2_t __attribute__((ext_vector_type(2)));
typedef float f32x2_t __attribute__((ext_vector_type(2)));
typedef short s16x2_t __attribute__((ext_vector_type(2)));
DEVI unsigned pk2(float lo, float hi) { f32x2_t v = {lo, hi}; bf16v2_t r = __builtin_convertvector(v, bf16v2_t); return __builtin_bit_cast(unsigned, r); }
DEVI unsigned f2bf(float f) { return pk2(f, 0.f) & 0xffffu; }
DEVI float bf2f(unsigned h) { return __uint_as_float(h << 16); }
DEVI unsigned relu2_bf16(unsigned x) { s16x2_t v = __builtin_bit_cast(s16x2_t, x); const s16x2_t z = {0, 0}; v = __builtin_elementwise_max(v, z); return __builtin_bit_cast(unsigned, v); }
extern "C" __device__ unsigned __ockl_wfred_max_u32(unsigned);
DEVI float bflo(unsigned w) { return __uint_as_float(w << 16); }
DEVI float bfhi(unsigned w) { return __uint_as_float(w & 0xffff0000u); }
extern "C" __device__ float __ockl_wfred_add_f32(float);
DEVI float wave_sum(float v) { return __ockl_wfred_add_f32(v); }
DEVI float sigmoidf_(float z) { return __builtin_amdgcn_rcpf(1.0f + __builtin_amdgcn_exp2f(-1.4426950408889634f * z)); }
DEVI float siluf_(float z) { return z * __builtin_amdgcn_rcpf(1.0f + __builtin_amdgcn_exp2f(-1.4426950408889634f * z)); }

DEVI int tile_off(int row, int chunk) { return row * 128 + ((chunk ^ (row & 7)) << 4); }

DEVI int gemm_kc(int tid) { return ((tid & 7) ^ ((tid >> 3) & 7)) * 8; }
typedef __attribute__((address_space(3))) unsigned lds_u32_t;
DEVI void gemm128(f32x4 (&acc)[4][4], const bf16_t* const (&ap)[4], const bf16_t* const (&bp)[4], int KT, unsigned char* lds, int tid) {
    const int lane = tid & 63, wave = __builtin_amdgcn_readfirstlane(tid >> 6), wr = wave >> 1, wc = wave & 1;
#pragma unroll
    for (int p = 0; p < 4; ++p) {
        __builtin_amdgcn_global_load_lds((const unsigned*)ap[p], (lds_u32_t*)(lds + (p * 256 + wave * 64) * 16), 16, 0, 0);
        __builtin_amdgcn_global_load_lds((const unsigned*)bp[p], (lds_u32_t*)(lds + 16384 + (p * 256 + wave * 64) * 16), 16, 0, 0);
    }
    __syncthreads();
    for (int kt = 0; kt < KT; ++kt) {
        unsigned char* As = lds + (kt & 1) * 32768;
        unsigned char* Bs = As + 16384;
        if (kt + 1 < KT) {
            unsigned char* An = lds + ((kt + 1) & 1) * 32768;
#pragma unroll
            for (int p = 0; p < 4; ++p) {
                __builtin_amdgcn_global_load_lds((const unsigned*)(ap[p] + (kt + 1) * 64), (lds_u32_t*)(An + (p * 256 + wave * 64) * 16), 16, 0, 0);
                __builtin_amdgcn_global_load_lds((const unsigned*)(bp[p] + (kt + 1) * 64), (lds_u32_t*)(An + 16384 + (p * 256 + wave * 64) * 16), 16, 0, 0);
            }
        }
#pragma unroll
        for (int ks = 0; ks < 2; ++ks) {
            bf16x8 a[4], b[4];
#pragma unroll
            for (int m = 0; m < 4; ++m) a[m] = *(const bf16x8*)(As + tile_off(wr * 64 + m * 16 + (lane & 15), ks * 4 + (lane >> 4)));
#pragma unroll
            for (int n = 0; n < 4; ++n) b[n] = *(const bf16x8*)(Bs + tile_off(wc * 64 + n * 16 + (lane & 15), ks * 4 + (lane >> 4)));
#pragma unroll
            for (int m = 0; m < 4; ++m)
#pragma unroll
                for (int n = 0; n < 4; ++n) acc[m][n] = __builtin_amdgcn_mfma_f32_16x16x32_bf16(b[n], a[m], acc[m][n], 0, 0, 0);
        }
        __syncthreads();
    }
}

DEVI void gemm128p(f32x4 (&acc)[4][4], const bf16_t* const (&ap)[4], const bf16_t* const (&bp)[4], int KT, unsigned char* lds, int tid,
                   int& par, bool pre, const bf16_t* const (&nap)[4], const bf16_t* const (&nbp)[4], bool has_next) {
    const int lane = tid & 63, wave = __builtin_amdgcn_readfirstlane(tid >> 6), wr = wave >> 1, wc = wave & 1;
    if (!pre) {
        unsigned char* A0 = lds + par * 32768;
#pragma unroll
        for (int p = 0; p < 4; ++p) {
            __builtin_amdgcn_global_load_lds((const unsigned*)ap[p], (lds_u32_t*)(A0 + (p * 256 + wave * 64) * 16), 16, 0, 0);
            __builtin_amdgcn_global_load_lds((const unsigned*)bp[p], (lds_u32_t*)(A0 + 16384 + (p * 256 + wave * 64) * 16), 16, 0, 0);
        }
        __syncthreads();
    }
    for (int kt = 0; kt < KT; ++kt) {
        const int cur = (par + kt) & 1;
        unsigned char* As = lds + cur * 32768;
        unsigned char* Bs = As + 16384;
        unsigned char* An = lds + (cur ^ 1) * 32768;
        if (kt + 1 < KT) {
#pragma unroll
            for (int p = 0; p < 4; ++p) {
                __builtin_amdgcn_global_load_lds((const unsigned*)(ap[p] + (kt + 1) * 64), (lds_u32_t*)(An + (p * 256 + wave * 64) * 16), 16, 0, 0);
                __builtin_amdgcn_global_load_lds((const unsigned*)(bp[p] + (kt + 1) * 64), (lds_u32_t*)(An + 16384 + (p * 256 + wave * 64) * 16), 16, 0, 0);
            }
        } else if (has_next) {
#pragma unroll
            for (int p = 0; p < 4; ++p) {
                __builtin_amdgcn_global_load_lds((const unsigned*)nap[p], (lds_u32_t*)(An + (p * 256 + wave * 64) * 16), 16, 0, 0);
                __builtin_amdgcn_global_load_lds((const unsigned*)nbp[p], (lds_u32_t*)(An + 16384 + (p * 256 + wave * 64) * 16), 16, 0, 0);
            }
        }
#pragma unroll
        for (int ks = 0; ks < 2; ++ks) {
            bf16x8 a[4], b[4];
#pragma unroll
            for (int m = 0; m < 4; ++m) a[m] = *(const bf16x8*)(As + tile_off(wr * 64 + m * 16 + (lane & 15), ks * 4 + (lane >> 4)));
#pragma unroll
            for (int n = 0; n < 4; ++n) b[n] = *(const bf16x8*)(Bs + tile_off(wc * 64 + n * 16 + (lane & 15), ks * 4 + (lane >> 4)));
#pragma unroll
            for (int m = 0; m < 4; ++m)
#pragma unroll
                for (int n = 0; n < 4; ++n) acc[m][n] = __builtin_amdgcn_mfma_f32_16x16x32_bf16(b[n], a[m], acc[m][n], 0, 0, 0);
        }
        __syncthreads();
    }
    par = (par + KT) & 1;
}

DEVI int bperm(int R) { return (R & 64) | (((R & 15) >> 2) << 4) | (((R >> 4) & 3) << 2) | (R & 3); }
DEVI unsigned pk4_fp8(float a, float b, float c, float d) {
    a = fminf(fmaxf(a, -440.f), 440.f); b = fminf(fmaxf(b, -440.f), 440.f); c = fminf(fmaxf(c, -440.f), 440.f); d = fminf(fmaxf(d, -440.f), 440.f);
    int w = __builtin_amdgcn_cvt_pk_fp8_f32(a, b, 0, false);
    return (unsigned)__builtin_amdgcn_cvt_pk_fp8_f32(c, d, w, true);
}
constexpr float F8_H2 = 8.0f, F8_WGU = 256.0f, F8_ACT = 64.0f, F8_WD = 128.0f;
constexpr float F8_H = 8.0f, F8_WIN = 256.0f;
constexpr float F8_O = 16.0f, F8_G = 256.0f;
constexpr float F8_Y = 64.0f;
constexpr float F8_OA = 16.0f, F8_OB = 32.0f, F8_WP = 128.0f, F8_MIX = 32.0f, F8_WO = 256.0f;

DEVI int gemm_kcb(int tid) { return ((tid & 7) ^ ((tid >> 3) & 7)) * 16; }
DEVI void gemm128f8(f32x4 (&acc)[4][4], const unsigned char* const (&ap)[4], const unsigned char* const (&bp)[4], int KT, unsigned char* lds, int tid) {
    const int lane = tid & 63, wave = __builtin_amdgcn_readfirstlane(tid >> 6), wr = wave >> 1, wc = wave & 1;
#pragma unroll
    for (int p = 0; p < 4; ++p) {
        __builtin_amdgcn_global_load_lds((const unsigned*)ap[p], (lds_u32_t*)(lds + (p * 256 + wave * 64) * 16), 16, 0, 0);
        __builtin_amdgcn_global_load_lds((const unsigned*)bp[p], (lds_u32_t*)(lds + 16384 + (p * 256 + wave * 64) * 16), 16, 0, 0);
    }
    __syncthreads();
#pragma unroll 1
    for (int kt = 0; kt < KT; ++kt) {
        unsigned char* As = lds + (kt & 1) * 32768;
        unsigned char* Bs = As + 16384;
        if (kt + 1 < KT) {
            unsigned char* An = lds + ((kt + 1) & 1) * 32768;
#pragma unroll
            for (int p = 0; p < 4; ++p) {
                __builtin_amdgcn_global_load_lds((const unsigned*)(ap[p] + (kt + 1) * 128), (lds_u32_t*)(An + (p * 256 + wave * 64) * 16), 16, 0, 0);
                __builtin_amdgcn_global_load_lds((const unsigned*)(bp[p] + (kt + 1) * 128), (lds_u32_t*)(An + 16384 + (p * 256 + wave * 64) * 16), 16, 0, 0);
            }
        }
        i32x8 b[4];
        const int lr = lane & 15, c0 = (lane >> 4) * 2;
#pragma unroll
        for (int n = 0; n < 4; ++n) {
            const u32x4 x0 = *(const u32x4*)(Bs + tile_off(wc * 64 + n * 16 + lr, c0)), x1 = *(const u32x4*)(Bs + tile_off(wc * 64 + n * 16 + lr, c0 + 1));
            b[n] = (i32x8){(int)x0.x, (int)x0.y, (int)x0.z, (int)x0.w, (int)x1.x, (int)x1.y, (int)x1.z, (int)x1.w};
        }
#pragma unroll
        for (int m = 0; m < 4; ++m) {
            const u32x4 x0 = *(const u32x4*)(As + tile_off(wr * 64 + m * 16 + lr, c0)), x1 = *(const u32x4*)(As + tile_off(wr * 64 + m * 16 + lr, c0 + 1));
            const i32x8 am = (i32x8){(int)x0.x, (int)x0.y, (int)x0.z, (int)x0.w, (int)x1.x, (int)x1.y, (int)x1.z, (int)x1.w};
#pragma unroll
            for (int n = 0; n < 4; ++n) acc[m][n] = __builtin_amdgcn_mfma_scale_f32_16x16x128_f8f6f4(b[n], am, acc[m][n], 0, 0, 0, 127, 0, 127);
        }
        __syncthreads();
    }
}

DEVI void zero_acc(f32x4 (&acc)[4][4]) {
#pragma unroll
    for (int m = 0; m < 4; ++m)
#pragma unroll
        for (int n = 0; n < 4; ++n) acc[m][n] = (f32x4){0.f, 0.f, 0.f, 0.f};
}

DEVI void gemm256b(f32x4 (&acc)[8][4], const bf16_t* a0, const bf16_t* b0, int lda, int ldb, int KT  , unsigned char* lds, int tid,
                   bool pre, int dna, int dnb, bool has_next, bool permb) {
    const int lane = tid & 63, wave = __builtin_amdgcn_readfirstlane(tid >> 6), wr = wave >> 1, wc = wave & 1;
    auto issueA = [&](const bf16_t* src) {
#pragma unroll
        for (int p = 0; p < 8; ++p) __builtin_amdgcn_global_load_lds((const unsigned*)(src + (size_t)p * 32 * lda), (lds_u32_t*)(lds + (p * 256 + wave * 64) * 16), 16, 0, 0);
    };
    auto issueB = [&](const bf16_t* src, int buf) {
        unsigned char* Bn = lds + 32768 + buf * 16384;
#pragma unroll
        for (int p = 0; p < 4; ++p) __builtin_amdgcn_global_load_lds((const unsigned*)(src + (size_t)(permb ? (p >> 1) * 64 + (p & 1) * 8 : p * 32) * ldb), (lds_u32_t*)(Bn + (p * 256 + wave * 64) * 16), 16, 0, 0);
    };
    if (!pre) { issueA(a0); issueB(b0, 0); }
    for (int kt = 0; kt < KT; ++kt) {
        __syncthreads();
        if (kt + 1 < KT) issueB(b0 + (kt + 1) * 64, (kt + 1) & 1);
        const unsigned char* Bs = lds + 32768 + (kt & 1) * 16384;
        bf16x8 a[8], b[4];
#pragma unroll
        for (int m = 0; m < 8; ++m) a[m] = *(const bf16x8*)(lds + tile_off(wr * 128 + m * 16 + (lane & 15), lane >> 4));
#pragma unroll
        for (int n = 0; n < 4; ++n) b[n] = *(const bf16x8*)(Bs + tile_off(wc * 64 + n * 16 + (lane & 15), lane >> 4));
#pragma unroll
        for (int m = 0; m < 8; ++m)
#pragma unroll
            for (int n = 0; n < 4; ++n) acc[m][n] = __builtin_amdgcn_mfma_f32_16x16x32_bf16(b[n], a[m], acc[m][n], 0, 0, 0);
#pragma unroll
        for (int m = 0; m < 8; ++m) a[m] = *(const bf16x8*)(lds + tile_off(wr * 128 + m * 16 + (lane & 15), 4 + (lane >> 4)));
#pragma unroll
        for (int n = 0; n < 4; ++n) b[n] = *(const bf16x8*)(Bs + tile_off(wc * 64 + n * 16 + (lane & 15), 4 + (lane >> 4)));
        asm volatile("" ::: "memory");
        __builtin_amdgcn_s_waitcnt(0xC07F);
        __builtin_amdgcn_s_barrier();
        asm volatile("" ::: "memory");
        if (kt + 1 < KT) issueA(a0 + (kt + 1) * 64);
#pragma unroll
        for (int m = 0; m < 8; ++m)
#pragma unroll
            for (int n = 0; n < 4; ++n) acc[m][n] = __builtin_amdgcn_mfma_f32_16x16x32_bf16(b[n], a[m], acc[m][n], 0, 0, 0);
    }
    __syncthreads();
    if (has_next) { issueA(a0 + dna); issueB(b0 + dnb, 0); }
}

#define XB_TMO      128
#define XB_XCNT(j)  (256  + 64 * (j))
#define XB_XSUB(j)  (1280 + 64 * (j))
#define XB_XGEN(j)  (2304 + 64 * (j))
#define XB_TOP      3328
#define XB_TOPGEN   3392
#define XCD_BAR_WORDS 3456
#define XB_SPIN_CAP (1u << 20)
#define LAS __attribute__((address_space(3)))
DEVI unsigned xb_ld(unsigned* p)              { return __hip_atomic_load(p, __ATOMIC_RELAXED, __HIP_MEMORY_SCOPE_AGENT); }
DEVI unsigned xb_add(unsigned* p, unsigned v) { return __hip_atomic_fetch_add(p, v, __ATOMIC_RELAXED, __HIP_MEMORY_SCOPE_AGENT); }
DEVI unsigned xb_xcc_id() { return (unsigned)__builtin_amdgcn_s_getreg((3 << 11) | 20) & 0xFu; }
#define XB_SPIN(cond, bar) do { unsigned _sp = 0; while (cond) { __builtin_amdgcn_s_sleep(1); \
    if ((++_sp & 255u) == 0u) { if (xb_ld(&(bar)[XB_TMO])) break; if (_sp > XB_SPIN_CAP) { atomicAdd(&(bar)[XB_TMO], 1u); break; } } } } while (0)
struct XcdBarrier { unsigned* bar; unsigned x; volatile LAS unsigned* st; };
DEVI XcdBarrier xcd_barrier_post(unsigned* bar, volatile LAS unsigned* st) {
    XcdBarrier b; b.bar = bar; b.x = xb_xcc_id(); b.st = st;
    if (threadIdx.x == 0) (void)xb_add(&bar[XB_XCNT(b.x)], 1u);
    return b;
}
DEVI void xcd_barrier_complete(unsigned* bar, unsigned x, unsigned& nloc, unsigned& nx) {
    const unsigned G = gridDim.x * gridDim.y * gridDim.z;
    unsigned sum, cnt, mine, sp = 0u;
    for (;;) {
        sum = 0u; cnt = 0u; mine = 0u;
#pragma unroll
        for (unsigned j = 0; j < 16; ++j) { const unsigned c = xb_ld(&bar[XB_XCNT(j)]); sum += c; cnt += (c > 0u) ? 1u : 0u; mine = (j == x) ? c : mine; }
        if (sum == G) break;
        __builtin_amdgcn_s_sleep(1);
        if ((++sp & 255u) == 0u) { if (xb_ld(&bar[XB_TMO])) break; if (sp > XB_SPIN_CAP) { atomicAdd(&bar[XB_TMO], 1u); break; } }
    }
    nloc = mine > 0u ? mine : 1u; nx = cnt > 0u ? cnt : 1u;
}
DEVI void xcd_barrier(const XcdBarrier& b) {
    asm volatile("s_waitcnt vmcnt(0)" ::: "memory");
    __syncthreads();
    if (threadIdx.x == 0) {
        unsigned* bar = b.bar;
        __builtin_amdgcn_s_waitcnt(0);
        unsigned nloc = b.st[0], nx = b.st[1];
        if (nloc == 0u) { xcd_barrier_complete(bar, b.x, nloc, nx); b.st[0] = nloc; b.st[1] = nx; }
        const unsigned old = xb_add(&bar[XB_XSUB(b.x)], 1u);
        const unsigned gen = old / nloc;
        if (old + 1u == (gen + 1u) * nloc) {
            __builtin_amdgcn_fence(__ATOMIC_RELEASE, "agent");
            asm volatile("s_waitcnt vmcnt(0)" ::: "memory");
            const unsigned og = xb_add(&bar[XB_TOP], 1u);
            const unsigned tg = og / nx;
            if (og + 1u == (tg + 1u) * nx) xb_add(&bar[XB_TOPGEN], 1u);
            else XB_SPIN(xb_ld(&bar[XB_TOPGEN]) == tg, bar);
            __builtin_amdgcn_fence(__ATOMIC_ACQUIRE, "agent");
            xb_add(&bar[XB_XGEN(b.x)], 1u);
            asm volatile("s_waitcnt vmcnt(0)" ::: "memory");
        } else {
            XB_SPIN(xb_ld(&bar[XB_XGEN(b.x)]) == gen, bar);
            __builtin_amdgcn_fence(__ATOMIC_ACQUIRE, "agent");
            asm volatile("s_waitcnt vmcnt(0)" ::: "memory");
        }
    }
    __syncthreads();
}

DEVI int f8_tile(int nt) { return (nt >= 20 && nt < 24) ? nt - 20 : (nt >= 28 && nt < 44) ? nt - 24 : -1; }
DEVI int f8_nt(int f) { return f < 4 ? f + 20 : f + 24; }
DEVI int win_src_col(int n) {
    if (n < 1536) return n;
    if (n < 3584) return n + 16;
    if (n < 5632) return n + 88;
    if (n < 5696) return n - 5632 + 3600;
    if (n < 5712) return n - 5696 + 1536;
    if (n < 5720) return n - 5712 + 3664;
    return -1;
}

struct TDesc { const float* sp; int ld; bf16_t* dst; int ld_dst; int n0, k0; float q8; };
DEVI TDesc tile_desc(const Params& p, int it, int tid) {
    constexpr int T0 = 1440, T1 = T0 + 128, T2 = T1 + 128, T3 = T2 + 256, T4 = T3 + 4096;
    unsigned char* dout = (unsigned char*)p.out;
    TDesc d; d.q8 = 0.f; const int nn = (tid & 15) * 4;
    if (it < T0) {
        d.n0 = (it >> 4) * 64; d.k0 = (it & 15) * 64; d.ld = DIN; d.dst = (bf16_t*)(dout + DO_WIN); d.ld_dst = 1024;
        const int f8t = f8_tile(d.n0 >> 7);
        const int sc = win_src_col(d.n0 + nn);
        d.sp = sc >= 0 ? p.w_in + sc : nullptr;
        if (f8t >= 0) { d.dst = (bf16_t*)(dout + DO_WG8); d.n0 = f8t * 128 + (d.n0 & 127); d.q8 = F8_WIN; }
    } else if (it < T2) {
        const bool second = it >= T1; const int j = it - (second ? T1 : T0);
        d.n0 = (j >> 3) * 64; d.k0 = (j & 7) * 64; d.ld = 1024; d.dst = (bf16_t*)(dout + (second ? DO_WPD : DO_WPG)); d.ld_dst = 512; d.q8 = F8_WP;
        d.sp = (second ? p.w_proj_dsa : p.w_proj_gla) + d.n0 + nn;
    } else if (it < T3) {
        const int j = it - T2;
        d.n0 = (j >> 4) * 64; d.k0 = (j & 15) * 64; d.ld = 1024; d.dst = (bf16_t*)(dout + DO_WOUT); d.ld_dst = 1024; d.q8 = F8_WO;
        d.sp = p.w_out + d.n0 + nn;
    } else if (it < T4) {
        const int j = it - T3, e = j >> 7, r = j & 127;
        d.n0 = (r >> 4) * 64; d.k0 = (r & 15) * 64; d.ld = 256; d.dst = (bf16_t*)(p.ws + WS_WGU + (size_t)e * 512 * 1024); d.ld_dst = 1024; d.q8 = F8_WGU;
        const int n = d.n0 + nn, ns = (n >> 4) & 3, f = (n >> 7) * 64 + ((n >> 6) & 1) * 32 + (ns >> 1) * 16 + (n & 15);
        d.sp = ((ns & 1) ? p.w_eu : p.w_eg) + (size_t)e * 1024 * 256 + f;
    } else {
        const int j = it - T4, e = j >> 6, r = j & 63;
        d.n0 = (r >> 2) * 64; d.k0 = (r & 3) * 64; d.ld = 1024; d.dst = (bf16_t*)(p.ws + WS_WD + (size_t)e * 1024 * 256); d.ld_dst = 256; d.q8 = F8_WD;
        d.sp = p.w_ed + (size_t)e * 256 * 1024 + d.n0 + nn;
    }
    return d;
}
DEVI void tile_load(const TDesc& d, f32x4 (&v4)[4], int tid) {
#pragma unroll
    for (int i = 0; i < 4; ++i) v4[i] = d.sp ? __builtin_nontemporal_load((const f32x4*)(d.sp + (size_t)(d.k0 + i * 16 + (tid >> 4)) * d.ld)) : (f32x4){0.f, 0.f, 0.f, 0.f};
}
DEVI void tile_finish(const TDesc& d, const f32x4 (&v4)[4], float* tl  , int tid) {
    __syncthreads();
#pragma unroll
    for (int i = 0; i < 4; ++i) {
        const int kk = i * 16 + (tid >> 4), nn = (tid & 15) * 4;
        tl[kk * 65 + nn] = v4[i][0]; tl[kk * 65 + nn + 1] = v4[i][1]; tl[kk * 65 + nn + 2] = v4[i][2]; tl[kk * 65 + nn + 3] = v4[i][3];
    }
    __syncthreads();
#pragma unroll
    for (int p2 = 0; p2 < 2; ++p2) {
        const int nn = p2 * 32 + (tid >> 3), ch = tid & 7;
        float v[8];
#pragma unroll
        for (int j = 0; j < 8; ++j) v[j] = tl[(ch * 8 + j) * 65 + nn];
        u32x4 w; w.x = pk2(v[0], v[1]); w.y = pk2(v[2], v[3]); w.z = pk2(v[4], v[5]); w.w = pk2(v[6], v[7]);
        if (d.q8 > 0.f) {
            u32x2 w8; w8.x = pk4_fp8(v[0] * d.q8, v[1] * d.q8, v[2] * d.q8, v[3] * d.q8); w8.y = pk4_fp8(v[4] * d.q8, v[5] * d.q8, v[6] * d.q8, v[7] * d.q8);
            *(u32x2*)((unsigned char*)d.dst + (size_t)(d.n0 + nn) * d.ld_dst + d.k0 + ch * 8) = w8;
        } else *(u32x4*)(d.dst + (size_t)(d.n0 + nn) * d.ld_dst + d.k0 + ch * 8) = w;
    }
}

static DEVI void phase0(const Params& p, unsigned char* lds, int tid) {
    float* tl = (float*)lds;
    const int nb = gridDim.x, b = blockIdx.x;
    unsigned char* dout = (unsigned char*)p.out;
    for (int it = b; it < 192; it += nb) {
        const int col = it * 32 + (tid & 31), kg = tid >> 5;
        float s = 0.f;
        for (int k0 = 0; k0 < 1024; k0 += 128) {
            float wv[16], cv[16];
#pragma unroll
            for (int j = 0; j < 16; ++j) { const int k = k0 + j * 8 + kg; wv[j] = __builtin_nontemporal_load(p.w_ada + (size_t)k * 6144 + col); cv[j] = p.c[k]; }
#pragma unroll
            for (int j = 0; j < 16; ++j) s += siluf_(cv[j]) * wv[j];
        }
        __syncthreads();
        tl[tid] = s;
        __syncthreads();
        if (tid < 32) {
            float t = 0.f;
#pragma unroll
            for (int g = 0; g < 8; ++g) t += tl[g * 32 + tid];
            ((float*)(p.ws + WS_MOD))[col] = t + p.b_ada[col];
            __threadfence();
        }
        if (it < 64) {
            __syncthreads();
            if (tid == 0) __hip_atomic_fetch_add((unsigned*)(p.ws + WS_CNT) + 1, 1u, __ATOMIC_RELEASE, __HIP_MEMORY_SCOPE_AGENT);
        }
    }
    for (int it = b; it < 192; it += nb) {
        const int e = it * 256 + tid, row = e >> 10, k = e & 1023;
        float v = 0.f;
        if (row < 4) v = p.w_rg[(size_t)k * 4 + row]; else if (row < 36) v = p.w_re[(size_t)k * 32 + (row - 4)];
        ((bf16_t*)(p.ws + WS_WRT))[e] = (bf16_t)(pk2(v, 0.f) & 0xffffu);
    }
    for (int it = b; it < 512; it += nb) {
        const int e = it * 256 + tid, t = e >> 3, i = e & 7;
        const double fr[8] = {1.0, 0.19392274474868576, 0.03760603093086393, 0.007292664737217109, 0.001414213562373095, 0.0002742481756762073, 5.318295896944988e-05, 1.031338537721246e-05};
        double f = fr[0];
#pragma unroll
        for (int q = 1; q < 8; ++q) f = (i == q) ? fr[q] : f;
        const float ang32 = (float)p.pos[t] * (float)f;
        const double rev = (double)ang32 * 0.15915494309189535;
        const float fracr = (float)(rev - floor(rev));
        float2 cs; cs.x = __builtin_amdgcn_cosf(fracr); cs.y = __builtin_amdgcn_sinf(fracr);
        ((float2*)(p.ws + WS_ROPE))[e] = cs;
    }
    constexpr int T5 = 1440 + 128 + 128 + 256 + 4096 + 2048;
    if (b < T5) {
        TDesc d = tile_desc(p, b, tid);
        f32x4 v4[4]; tile_load(d, v4, tid);
        for (int it = b; it < T5; it += nb) {
            const int itn = it + nb;
            TDesc dn = d; f32x4 vn[4];
            if (itn < T5) { dn = tile_desc(p, itn, tid); tile_load(dn, vn, tid); }
            tile_finish(d, v4, tl, tid);
            if (itn < T5) {
                d = dn;
#pragma unroll
                for (int i = 0; i < 4; ++i) v4[i] = vn[i];
            }
        }
    }
}

static DEVI void phase1(const Params& p, int tid) {
    const int lane = tid & 63, gw = blockIdx.x * 4 + __builtin_amdgcn_readfirstlane(tid >> 6), nw = gridDim.x * 4;
    const float* mod = (const float*)(p.ws + WS_MOD);
    bf16_t* h = (bf16_t*)((unsigned char*)p.out + DO_H);
    if (tid == 0) { while (__hip_atomic_load((unsigned*)(p.ws + WS_CNT) + 1, __ATOMIC_ACQUIRE, __HIP_MEMORY_SCOPE_AGENT) < 64u) __builtin_amdgcn_s_sleep(2); }
    __syncthreads();
    f32x4 A[4], B[4];
#pragma unroll
    for (int i = 0; i < 4; ++i) {
        const int c0 = i * 256 + lane * 4;
        const f32x4 g = *(const f32x4*)(p.g_pre_mix + c0), sc = *(const f32x4*)(mod + 1024 + c0);
        A[i] = g * (sc + 1.0f); B[i] = *(const f32x4*)(mod + c0);
    }
    for (int r = gw; r < S; r += 2 * nw) {
        const int r1 = r + nw; const bool has1 = r1 < S;
        f32x4 v[4], u[4]; float ss = 0.f, su = 0.f;
#pragma unroll
        for (int i = 0; i < 4; ++i) { v[i] = __builtin_nontemporal_load((const f32x4*)(p.x + (size_t)r * D + i * 256 + lane * 4)); u[i] = __builtin_nontemporal_load((const f32x4*)(p.x + (size_t)(has1 ? r1 : r) * D + i * 256 + lane * 4)); }
#pragma unroll
        for (int i = 0; i < 4; ++i) { ss += v[i][0] * v[i][0] + v[i][1] * v[i][1] + v[i][2] * v[i][2] + v[i][3] * v[i][3]; su += u[i][0] * u[i][0] + u[i][1] * u[i][1] + u[i][2] * u[i][2] + u[i][3] * u[i][3]; }
        ss = wave_sum(ss); su = wave_sum(su);
        const float rstd = rsqrtf(ss * (1.0f / 1024.0f) + EPS), rstu = rsqrtf(su * (1.0f / 1024.0f) + EPS);
#pragma unroll
        for (int i = 0; i < 4; ++i) {
            const f32x4 y = v[i] * rstd * A[i] + B[i];
            u32x2 w; w.x = pk2(y[0], y[1]); w.y = pk2(y[2], y[3]);
            *(u32x2*)(h + (size_t)r * D + i * 256 + lane * 4) = w;
            *(unsigned*)(p.ws + WS_H8 + (size_t)r * 1024 + i * 256 + lane * 4) = pk4_fp8(y[0] * F8_H, y[1] * F8_H, y[2] * F8_H, y[3] * F8_H);
            if (has1) {
                const f32x4 z = u[i] * rstu * A[i] + B[i];
                u32x2 w1; w1.x = pk2(z[0], z[1]); w1.y = pk2(z[2], z[3]);
                *(u32x2*)(h + (size_t)r1 * D + i * 256 + lane * 4) = w1;
                *(unsigned*)(p.ws + WS_H8 + (size_t)r1 * 1024 + i * 256 + lane * 4) = pk4_fp8(z[0] * F8_H, z[1] * F8_H, z[2] * F8_H, z[3] * F8_H);
            }
        }
    }
}

static DEVI void phase2(const Params& p, unsigned char* lds, int tid) {
    const int lane = tid & 63, wave = __builtin_amdgcn_readfirstlane(tid >> 6), wr = wave >> 1, wc = wave & 1;
    const int lr = lane & 15, lq = lane >> 4;
    const bf16_t* h = (const bf16_t*)((unsigned char*)p.out + DO_H);
    const bf16_t* wt = (const bf16_t*)((unsigned char*)p.out + DO_WIN);
    bf16_t* P = (bf16_t*)(p.ws + WS_P);
    bf16_t* KI = (bf16_t*)(p.ws + WS_KI);
    float* AUX = (float*)(p.ws + WS_AUX);
    const float2* rope = (const float2*)(p.ws + WS_ROPE);
    bool pre = false;
    auto ct2nt = [](int ct) { return ct < 20 ? ct : ct < 24 ? ct + 4 : 44; };
    for (int i = blockIdx.x; i < 1600; i += gridDim.x) {
        const int xcd = i & 7, j = i >> 3, nt = ct2nt(j >> 3), mt = xcd * 8 + (j & 7);
        const int inx = i + gridDim.x; const bool has_next = inx < 1600;
        const int jn = (has_next ? inx : i) >> 3, ntn = ct2nt(jn >> 3), mtn = xcd * 8 + (jn & 7);
        f32x4 acc[8][4];
#pragma unroll
        for (int m = 0; m < 8; ++m)
#pragma unroll
            for (int n = 0; n < 4; ++n) acc[m][n] = (f32x4){0.f, 0.f, 0.f, 0.f};
        const int tb = tid >> 3, bt = 16 * ((tb & 15) >> 2) + 4 * (tb >> 4) + (tb & 3);
        gemm256b(acc, h + (size_t)(mt * 256 + (tid >> 3)) * D + gemm_kc(tid), wt + (size_t)(nt * 128 + bt) * D + gemm_kc(tid), D, D, 16, lds, tid,
                 pre, (mtn - mt) * 256 * D, (ntn - nt) * 128 * D, has_next, true);
        pre = has_next;
        const int colw = nt * 128 + wc * 64;
        int kind;
        if (nt < 2) kind = 1; else if (nt < 12) kind = 0; else if (nt < 16) kind = 3; else if (nt < 20) kind = 2; else if (nt < 24) kind = 0; else if (nt < 28) kind = 2;
        else if (nt < 44) kind = 4; else kind = (wc == 0) ? 5 : 6;
#pragma unroll
        for (int m = 0; m < 8; ++m) {
            const int row = mt * 256 + wr * 128 + m * 16 + lr;
            f32x4 v[4];
#pragma unroll
            for (int n = 0; n < 4; ++n) v[n] = acc[m][n];
            if (kind == 5) {
                float s = 0.f;
#pragma unroll
                for (int n = 0; n < 4; ++n) s += (v[n][0] + v[n][1]) + (v[n][2] + v[n][3]);
                s += __shfl_xor(s, 16); s += __shfl_xor(s, 32);
                const float mu = s * (1.0f / 64.0f);
                float q = 0.f;
#pragma unroll
                for (int n = 0; n < 4; ++n) { v[n] = v[n] - mu; q += (v[n][0] * v[n][0] + v[n][1] * v[n][1]) + (v[n][2] * v[n][2] + v[n][3] * v[n][3]); }
                q += __shfl_xor(q, 16); q += __shfl_xor(q, 32);
                const float rs = rsqrtf(q * (1.0f / 64.0f) + EPS);
#pragma unroll
                for (int n = 0; n < 4; ++n) v[n] = v[n] * rs * *(const f32x4*)(p.g_idx_k + lq * 16 + n * 4);
            }
            if ((kind == 2 || kind == 3 || kind == 5) && lq == 0) {
#pragma unroll
                for (int n = 0; n < 2; ++n)
#pragma unroll
                    for (int jj = 0; jj < 4; ++jj) {
                        const float2 cs = rope[(size_t)row * 8 + n * 4 + jj];
                        const float xa = v[n][jj], xb = v[n + 2][jj];
                        v[n][jj] = xa * cs.x - xb * cs.y; v[n + 2][jj] = xa * cs.y + xb * cs.x;
                    }
            }
            if (kind == 1 || kind == 3) {
#pragma unroll
                for (int n = 0; n < 4; ++n) v[n] = v[n] * 0.125f;
            }
            if (kind == 4) {
#pragma unroll
                for (int n = 0; n < 4; ++n)
#pragma unroll
                    for (int jj = 0; jj < 4; ++jj) v[n][jj] = sigmoidf_(v[n][jj]);
            }
            if (nt >= 16 && nt < 20) {
                const int head = (nt - 16) * 2 + wc;
                float am = 0.f;
#pragma unroll
                for (int n = 0; n < 4; ++n) am = fmaxf(fmaxf(am, fmaxf(fabsf(v[n][0]), fabsf(v[n][1]))), fmaxf(fabsf(v[n][2]), fabsf(v[n][3])));
                am = fmaxf(am, __shfl_xor(am, 16)); am = fmaxf(am, __shfl_xor(am, 32));
                const unsigned skb = pk2(am * (1.0f / 127.0f), 0.f) & 0xffffu;
                const float skf = bflo(skb), inv = skf > 0.f ? 1.0f / skf : 0.f;
                unsigned char* k8 = (unsigned char*)P + (size_t)row * (LDP * 2) + 4096 + head * 128;
                int w8[4];
#pragma unroll
                for (int n = 0; n < 4; ++n) {
                    int q4[4];
#pragma unroll
                    for (int jj = 0; jj < 4; ++jj) q4[jj] = (int)__builtin_rintf(fminf(fmaxf(v[n][jj] * inv, -127.f), 127.f));
                    w8[n] = (q4[0] & 0xff) | ((q4[1] & 0xff) << 8) | ((q4[2] & 0xff) << 16) | (q4[3] << 24);
                }
                *(u32x2*)(k8 + (2 * lq) * 16) = (u32x2){(unsigned)w8[0], (unsigned)w8[1]};
                *(u32x2*)(k8 + (2 * lq + 1) * 16) = (u32x2){(unsigned)w8[2], (unsigned)w8[3]};
                if (lq == 0) ((unsigned short*)(p.ws + WS_SKT))[head * S + row] = (unsigned short)skb;
            } else if (nt >= 20 && nt < 24) {
                const int head = (nt - 20) * 2 + wc;
                unsigned char* kv8 = (unsigned char*)P + (size_t)row * (LDP * 2) + 4096 + head * 128 + 8;
                int w8[4];
#pragma unroll
                for (int n = 0; n < 4; ++n) {
                    f32x4 c = v[n] * 8.0f;
#pragma unroll
                    for (int jj = 0; jj < 4; ++jj) c[jj] = fminf(fmaxf(c[jj], -440.f), 440.f);
                    int w = __builtin_amdgcn_cvt_pk_fp8_f32(c[0], c[1], 0, false);
                    w8[n] = __builtin_amdgcn_cvt_pk_fp8_f32(c[2], c[3], w, true);
                }
                *(u32x2*)(kv8 + (2 * lq) * 16) = (u32x2){(unsigned)w8[0], (unsigned)w8[1]};
                *(u32x2*)(kv8 + (2 * lq + 1) * 16) = (u32x2){(unsigned)w8[2], (unsigned)w8[3]};
            } else if ((nt >= 24 && nt < 28) || kind == 5) {
                u32x4 w8;
#pragma unroll
                for (int n = 0; n < 4; ++n) {
                    f32x4 c = v[n] * 8.0f;
#pragma unroll
                    for (int jj = 0; jj < 4; ++jj) c[jj] = fminf(fmaxf(c[jj], -440.f), 440.f);
                    int w = __builtin_amdgcn_cvt_pk_fp8_f32(c[0], c[1], 0, false);
                    w8[n] = (unsigned)__builtin_amdgcn_cvt_pk_fp8_f32(c[2], c[3], w, true);
                }
                if (kind == 5) *(u32x4*)((unsigned char*)KI + (size_t)(row >> 5) * 2048 + (lq & 1) * 1024 + ((lq >> 1) * 32 + (row & 31)) * 16) = w8;
                else *(u32x4*)((unsigned char*)P + (size_t)row * (LDP * 2) + C_IQ * 2 + ((nt - 24) * 2 + wc) * 64 + lq * 16) = w8;
            } else if (kind == 4) {
                u32x4 w8;
#pragma unroll
                for (int n = 0; n < 4; ++n) w8[n] = pk4_fp8(v[n][0] * F8_G, v[n][1] * F8_G, v[n][2] * F8_G, v[n][3] * F8_G);
                *(u32x4*)((unsigned char*)P + (size_t)row * (LDP * 2) + C_BG * 2 + (colw - C_BG) + lq * 16) = w8;
            } else if (kind == 6) {
                if (lq == 0) {
#pragma unroll
                    for (int n = 0; n < 4; ++n) *(f32x4*)(AUX + (size_t)row * 32 + n * 4) = v[n];
                } else if (lq == 1) {
#pragma unroll
                    for (int n = 0; n < 2; ++n) *(f32x4*)(AUX + (size_t)row * 32 + 16 + n * 4) = v[n] * (0.35355339059327379f * 0.125f * (1.0f / 64.0f));
                }
            } else {
#pragma unroll
                for (int h2 = 0; h2 < 2; ++h2) {
                    u32x4 w; w.x = pk2(v[2 * h2][0], v[2 * h2][1]); w.y = pk2(v[2 * h2][2], v[2 * h2][3]); w.z = pk2(v[2 * h2 + 1][0], v[2 * h2 + 1][1]); w.w = pk2(v[2 * h2 + 1][2], v[2 * h2 + 1][3]);
                    *(u32x4*)(P + (size_t)row * LDP + colw + lq * 16 + h2 * 8) = w;
                }
            }
        }
    }
    {
        const unsigned char* H8 = p.ws + WS_H8;
        const unsigned char* WG8 = (const unsigned char*)p.out + DO_WG8;
        const int xq = blockIdx.x & 7;
        unsigned* queue = (unsigned*)(p.ws + WS_CNT) + 4 + xq;
        volatile int* qslot = (volatile int*)(lds + 65536 + 512);
        __syncthreads();
        if (tid == 0) *qslot = (int)__hip_atomic_fetch_add(queue, 1u, __ATOMIC_RELAXED, __HIP_MEMORY_SCOPE_AGENT);
        __syncthreads();
        int i = *qslot;
        while (i < 320) {
            unsigned nxt = 0;
            if (tid == 0) nxt = __hip_atomic_fetch_add(queue, 1u, __ATOMIC_RELAXED, __HIP_MEMORY_SCOPE_AGENT);
            const int grp = i / 160, r160 = i - grp * 160, f = r160 >> 3, mt = xq * 16 + grp * 8 + (r160 & 7), nt = f8_nt(f);
            const unsigned char* ap[4]; const unsigned char* bp[4];
#pragma unroll
            for (int q = 0; q < 4; ++q) {
                ap[q] = H8 + (size_t)(mt * 128 + q * 32 + (tid >> 3)) * 1024 + gemm_kcb(tid);
                bp[q] = WG8 + (size_t)(f * 128 + bperm(q * 32 + (tid >> 3))) * 1024 + gemm_kcb(tid);
            }
            f32x4 acc[4][4]; zero_acc(acc);
            gemm128f8(acc, ap, bp, 8, lds, tid);
            const int wr4 = wave >> 1, wc4 = wave & 1;
#pragma unroll
            for (int m = 0; m < 4; ++m) {
                const int row = mt * 128 + wr4 * 64 + m * 16 + lr;
                f32x4 x[4];
#pragma unroll
                for (int n = 0; n < 4; ++n) x[n] = acc[m][n] * (1.0f / (F8_H * F8_WIN));
                if (f >= 4) {
                    u32x4 w8;
#pragma unroll
                    for (int n = 0; n < 4; ++n) w8[n] = pk4_fp8(sigmoidf_(x[n][0]) * F8_G, sigmoidf_(x[n][1]) * F8_G, sigmoidf_(x[n][2]) * F8_G, sigmoidf_(x[n][3]) * F8_G);
                    *(u32x4*)((unsigned char*)P + (size_t)row * (LDP * 2) + C_BG * 2 + (nt - 28) * 128 + wc4 * 64 + lq * 16) = w8;
                } else if (f >= 0) {
                    const int head = (nt - 20) * 2 + wc4;
                    unsigned char* kv8 = (unsigned char*)P + (size_t)row * (LDP * 2) + 4096 + head * 128 + 8;
                    u32x2 v0, v1;
                    v0.x = pk4_fp8(x[0][0] * 8.f, x[0][1] * 8.f, x[0][2] * 8.f, x[0][3] * 8.f); v0.y = pk4_fp8(x[1][0] * 8.f, x[1][1] * 8.f, x[1][2] * 8.f, x[1][3] * 8.f);
                    v1.x = pk4_fp8(x[2][0] * 8.f, x[2][1] * 8.f, x[2][2] * 8.f, x[2][3] * 8.f); v1.y = pk4_fp8(x[3][0] * 8.f, x[3][1] * 8.f, x[3][2] * 8.f, x[3][3] * 8.f);
                    *(u32x2*)(kv8 + (2 * lq) * 16) = v0; *(u32x2*)(kv8 + (2 * lq + 1) * 16) = v1;
                } else {
#pragma unroll
                    for (int h2 = 0; h2 < 2; ++h2) {
                        u32x4 w; w.x = pk2(x[2 * h2][0], x[2 * h2][1]); w.y = pk2(x[2 * h2][2], x[2 * h2][3]); w.z = pk2(x[2 * h2 + 1][0], x[2 * h2 + 1][1]); w.w = pk2(x[2 * h2 + 1][2], x[2 * h2 + 1][3]);
                        *(u32x4*)(P + (size_t)row * LDP + nt * 128 + wc4 * 64 + lq * 16 + h2 * 8) = w;
                    }
                }
            }
            if (tid == 0) *qslot = (int)nxt;
            __syncthreads();
            i = *qslot;
        }
    }
}
constexpr int GL_QT = 0, GL_KT = 8192, GL_VT = 16384, GL_ST = 32768, GL_AM = 49152, GL_TOT = 57344;
DEVI int el_off(int row, int col) { return tile_off(row, col >> 3) + (col & 7) * 2; }

template <bool G3>
static DEVI void gla_item(const Params& p, int item, unsigned char* lds, int tid) {
    const int n = item >> 2, h = item & 3, t0 = n * 64;
    const int lane = tid & 63, wave = __builtin_amdgcn_readfirstlane(tid >> 6), lr = lane & 15, lq = lane >> 4;
    bf16_t* P = (bf16_t*)(p.ws + WS_P);
    const float* AUX = (const float*)(p.ws + WS_AUX);
    float* U = (float*)((unsigned char*)p.out + DO_H);
    float* GD = (float*)((unsigned char*)p.out + DO_GD);
    float* TOT = (float*)(lds + GL_TOT);
    __syncthreads();
    {
        const int d = tid & 63, tq = tid >> 6, colh = h * 64 + d;
        float w2r[16];
#pragma unroll
        for (int r = 0; r < 16; ++r) w2r[r] = p.w_gla_a2[r * 256 + colh];
        const float bb = p.b_gla_a[colh];
        float bc[16]; float run = 0.f;
#pragma unroll
        for (int i = 0; i < 16; ++i) {
            const float* ga = AUX + (size_t)(t0 + tq * 16 + i) * 32;
            float z = bb;
#pragma unroll
            for (int r4 = 0; r4 < 4; ++r4) { const f32x4 g = *(const f32x4*)(ga + r4 * 4); z += g[0] * w2r[r4 * 4] + g[1] * w2r[r4 * 4 + 1] + g[2] * w2r[r4 * 4 + 2] + g[3] * w2r[r4 * 4 + 3]; }
            const float ls = fminf(z, 0.f) - __logf(1.0f + __expf(-fabsf(z)));
            run += ls * (1.0f / 16.0f); bc[i] = run;
        }
        TOT[tq * 64 + d] = run;
        __syncthreads();
        float off = 0.f, blast = 0.f;
#pragma unroll
        for (int q = 0; q < 4; ++q) { const float v = TOT[q * 64 + d]; blast += v; off += (q < tq) ? v : 0.f; }
#pragma unroll
        for (int i = 0; i < 16; ++i) {
            const int tl = tq * 16 + i; const size_t rowp = (size_t)(t0 + tl) * LDP;
            const float b = bc[i] + off;
            const float kv = bf2f(P[rowp + C_GK + colh]);
            if (G3) {
                const float qv = bf2f(P[rowp + C_GQ + colh]);
                *(bf16_t*)(lds + GL_QT + el_off(tl, d)) = (bf16_t)f2bf(qv * __expf(b));
                *(bf16_t*)(lds + GL_KT + el_off(tl, d)) = (bf16_t)f2bf(kv * __expf(-b));
            } else {
                *(bf16_t*)(lds + GL_KT + el_off(d, tl)) = (bf16_t)f2bf(kv * __expf(blast - b));
            }
        }
        if (!G3 && tq == 0) GD[(size_t)item * 64 + d] = __expf(blast);
    }
    {
        const int v0 = (tid & 15) * 8;
#pragma unroll
        for (int i = 0; i < 4; ++i) {
            const int s = (tid >> 4) + 16 * i;
            const u32x4 w = *(const u32x4*)(P + (size_t)(t0 + s) * LDP + C_GV + h * 128 + v0);
            const unsigned ww[4] = {w.x, w.y, w.z, w.w};
#pragma unroll
            for (int j = 0; j < 8; ++j) *(bf16_t*)(lds + GL_VT + el_off(v0 + j, s)) = (bf16_t)((ww[j >> 1] >> ((j & 1) * 16)) & 0xffffu);
        }
    }
    if (G3) {
        const int v = tid & 127, dg = tid >> 7;
        const float* Sn = U + (size_t)item * 8192;
#pragma unroll 8
        for (int i = 0; i < 32; ++i) { const int d = dg * 32 + i; *(bf16_t*)(lds + GL_ST + el_off(v, d)) = (bf16_t)f2bf(__builtin_nontemporal_load(Sn + d * 128 + v)); }
    }
    __syncthreads();
    if (G3) {
        bf16x8 aq[2];
#pragma unroll
        for (int ks = 0; ks < 2; ++ks) aq[ks] = *(const bf16x8*)(lds + GL_QT + tile_off(wave * 16 + lr, ks * 4 + lq));
        const int tl = wave * 16 + lr;
#pragma unroll
        for (int nb = 0; nb < 4; ++nb) {
            f32x4 c = {0.f, 0.f, 0.f, 0.f};
#pragma unroll
            for (int ks = 0; ks < 2; ++ks) { const bf16x8 bk = *(const bf16x8*)(lds + GL_KT + tile_off(nb * 16 + lr, ks * 4 + lq)); c = __builtin_amdgcn_mfma_f32_16x16x32_bf16(bk, aq[ks], c, 0, 0, 0); }
#pragma unroll
            for (int j = 0; j < 4; ++j) c[j] = (nb * 16 + 4 * lq + j <= tl) ? c[j] : 0.f;
            u32x2 w; w.x = pk2(c[0], c[1]); w.y = pk2(c[2], c[3]);
            *(u32x2*)(lds + GL_AM + tile_off(tl, nb * 2 + (lq >> 1)) + (lq & 1) * 8) = w;
        }
        __syncthreads();
        bf16x8 am[2];
#pragma unroll
        for (int ks = 0; ks < 2; ++ks) am[ks] = *(const bf16x8*)(lds + GL_AM + tile_off(tl, ks * 4 + lq));
        f32x4 o[8]; float ss = 0.f;
#pragma unroll
        for (int vb = 0; vb < 8; ++vb) {
            f32x4 c = {0.f, 0.f, 0.f, 0.f};
#pragma unroll
            for (int ks = 0; ks < 2; ++ks) {
                const bf16x8 bs = *(const bf16x8*)(lds + GL_ST + tile_off(vb * 16 + lr, ks * 4 + lq));
                c = __builtin_amdgcn_mfma_f32_16x16x32_bf16(bs, aq[ks], c, 0, 0, 0);
                const bf16x8 bv = *(const bf16x8*)(lds + GL_VT + tile_off(vb * 16 + lr, ks * 4 + lq));
                c = __builtin_amdgcn_mfma_f32_16x16x32_bf16(bv, am[ks], c, 0, 0, 0);
            }
            o[vb] = c; ss += (c[0] * c[0] + c[1] * c[1]) + (c[2] * c[2] + c[3] * c[3]);
        }
        ss += __shfl_xor(ss, 16); ss += __shfl_xor(ss, 32);
        const float rstd = rsqrtf(ss * (1.0f / 128.0f) + EPS);
        const size_t rowp = (size_t)(t0 + tl) * LDP;
#pragma unroll
        for (int vb = 0; vb < 8; ++vb) {
            const int v0 = vb * 16 + 4 * lq;
            const u32x2 gg = *(const u32x2*)(P + rowp + C_GG + h * 128 + v0);
            const f32x4 g4 = *(const f32x4*)(p.g_gla_out + v0);
            const float y0 = o[vb][0] * rstd * g4[0] * siluf_(bflo(gg.x)), y1 = o[vb][1] * rstd * g4[1] * siluf_(bfhi(gg.x));
            const float y2 = o[vb][2] * rstd * g4[2] * siluf_(bflo(gg.y)), y3 = o[vb][3] * rstd * g4[3] * siluf_(bfhi(gg.y));
            *(unsigned*)((unsigned char*)P + rowp * 2 + B_OA8 + h * 128 + v0) = pk4_fp8(y0 * F8_OA, y1 * F8_OA, y2 * F8_OA, y3 * F8_OA);
        }
    } else {
        bf16x8 ak[2];
#pragma unroll
        for (int ks = 0; ks < 2; ++ks) ak[ks] = *(const bf16x8*)(lds + GL_KT + tile_off(wave * 16 + lr, ks * 4 + lq));
#pragma unroll
        for (int vb = 0; vb < 8; ++vb) {
            f32x4 c = {0.f, 0.f, 0.f, 0.f};
#pragma unroll
            for (int ks = 0; ks < 2; ++ks) { const bf16x8 bv = *(const bf16x8*)(lds + GL_VT + tile_off(vb * 16 + lr, ks * 4 + lq)); c = __builtin_amdgcn_mfma_f32_16x16x32_bf16(bv, ak[ks], c, 0, 0, 0); }
            *(f32x4*)(U + (size_t)item * 8192 + (wave * 16 + lr) * 128 + vb * 16 + 4 * lq) = c;
        }
    }
}

static DEVI void gla_scan(const Params& p, int tid) {
    float* U = (float*)((unsigned char*)p.out + DO_H);
    const float* GD = (const float*)((unsigned char*)p.out + DO_GD);
    for (int e = blockIdx.x * NT + tid; e < 32768; e += gridDim.x * NT) {
        const int hd = e >> 7;
        float st = 0.f;
        float u[32], g[32];
#pragma unroll
        for (int q = 0; q < 32; ++q) { u[q] = U[(size_t)q * 32768 + e]; g[q] = GD[(size_t)q * 256 + hd]; }
        for (int n0 = 0; n0 < 256; n0 += 32) {
            float un[32], gn[32];
            const int n1 = n0 + 32 < 256 ? n0 + 32 : n0;
#pragma unroll
            for (int q = 0; q < 32; ++q) { un[q] = U[(size_t)(n1 + q) * 32768 + e]; gn[q] = GD[(size_t)(n1 + q) * 256 + hd]; }
#pragma unroll
            for (int q = 0; q < 32; ++q) { U[(size_t)(n0 + q) * 32768 + e] = st; st = g[q] * st + u[q]; }
#pragma unroll
            for (int q = 0; q < 32; ++q) { u[q] = un[q]; g[q] = gn[q]; }
        }
    }
}

constexpr int TK_CAP = 1024, TK_K = 256, TK_WBYTES = 16384;
DEVI unsigned fkey(float f) { const unsigned b = __float_as_uint(f); return b ^ ((unsigned)((int)b >> 31) | 0x80000000u); }
DEVI int lane_prefix(unsigned long long m) { return __builtin_amdgcn_mbcnt_hi((unsigned)(m >> 32), __builtin_amdgcn_mbcnt_lo((unsigned)m, 0)); }

extern "C" __device__ unsigned __ockl_wfred_min_u32(unsigned);
template <int NB>
DEVI unsigned topk_prune_n(unsigned* s, int n, int kk, int slack, int lane, int& cnew) {
    unsigned u[NB]; unsigned mx = 0u, mn = 0xFFFFFFFFu;
#pragma unroll
    for (int i = 0; i < NB; ++i) { const int pos = i * 64 + lane; const unsigned v = s[pos]; const bool ok = pos < n; u[i] = ok ? v : 0u; mx = u[i] > mx ? u[i] : mx; const unsigned w = ok ? v : 0xFFFFFFFFu; mn = w < mn ? w : mn; }
    mx = __ockl_wfred_max_u32(mx);
    mn = __ockl_wfred_min_u32(mn);
    const int top = 31 - __builtin_clz((mx ^ mn) | 1u);
    unsigned T = (top >= 31) ? 0u : (mx & ~((2u << top) - 1u));
    int cT = n;
    for (int bit = top; bit >= 0; --bit) {
        const unsigned trial = T | (1u << bit);
        int c = 0;
#pragma unroll
        for (int b0 = 0; b0 < NB; b0 += 8) {
            unsigned long long bm[8];
#pragma unroll
            for (int i = 0; i < 8; ++i) if (b0 + i < NB) bm[i] = __ballot(u[b0 + i] >= trial);
#pragma unroll
            for (int i = 0; i < 8; ++i) if (b0 + i < NB) c += __builtin_popcountll(bm[i]);
        }
        if (c >= kk) { T = trial; cT = c; if (c <= kk + slack) break; }
    }
    int nb = 0;
#pragma unroll
    for (int i = 0; i < NB; ++i) {
        const bool keep = u[i] >= T;
        const unsigned long long km = __ballot(keep);
        if (keep) s[nb + lane_prefix(km)] = u[i];
        nb += __builtin_popcountll(km);
    }
    cnew = cT;
    return T;
}
DEVI unsigned topk_prune(unsigned* s, int n, int kk, int slack, int lane, int& cnew) {
    if (n <= 512) return topk_prune_n<8>(s, n, kk, slack, lane, cnew);
    if (n <= 640) return topk_prune_n<10>(s, n, kk, slack, lane, cnew);
    if (n <= 768) return topk_prune_n<12>(s, n, kk, slack, lane, cnew);
    return topk_prune_n<16>(s, n, kk, slack, lane, cnew);
}

static DEVI void topk_phase(const Params& p, unsigned char* lds, int tid) {
    const int lane = tid & 63, wave = __builtin_amdgcn_readfirstlane(tid >> 6), gw = blockIdx.x * 4 + wave, nw = gridDim.x * 4;
    const int r = lane & 31, hh = lane >> 5;
    const bf16_t* P = (const bf16_t*)(p.ws + WS_P);
    const bf16_t* KI = (const bf16_t*)(p.ws + WS_KI);
    const float* AUX = (const float*)(p.ws + WS_AUX);
    unsigned short* SEL = (unsigned short*)(p.ws + WS_SEL);
    int* SELC = (int*)(p.ws + WS_SELC);
    unsigned* cb = (unsigned*)(lds + wave * TK_WBYTES);
    for (int item = gw; item < 2048; item += nw) {
        int half = 0, mode = 0;
#pragma unroll 1
        while (half < 2) {
            const int qb = half ? 4 * (4095 - item) : 4 * item;
            const float inv_p = 1.0f / (float)(qb + 1);
            i32x8 a8; u32x4 wf[2];
            {
                const int qa = qb + ((r >> 2) & 1) + 2 * ((r >> 4) & 1), ha = (r & 3) + 4 * ((r >> 3) & 1);
                const unsigned char* qp = (const unsigned char*)P + (size_t)qa * (LDP * 2) + C_IQ * 2 + ha * 64 + 32 * hh;
                const u32x4 q0 = *(const u32x4*)qp, q1 = *(const u32x4*)(qp + 16);
                a8 = (i32x8){(int)q0.x, (int)q0.y, (int)q0.z, (int)q0.w, (int)q1.x, (int)q1.y, (int)q1.z, (int)q1.w};
            }
#pragma unroll
            for (int s = 0; s < 2; ++s) {
                const f32x4 w0 = *(const f32x4*)(AUX + (size_t)(qb + hh + 2 * s) * 32 + 16), w1 = *(const f32x4*)(AUX + (size_t)(qb + hh + 2 * s) * 32 + 20);
                const bool mine = (r == 4 * hh + s);
                u32x4 f; f.x = pk2(w0[0], w0[1]); f.y = pk2(w0[2], w0[3]); f.z = pk2(w1[0], w1[1]); f.w = pk2(w1[2], w1[3]);
                wf[s] = mine ? f : (u32x4){0u, 0u, 0u, 0u};
            }
            unsigned thr[4];
#pragma unroll
            for (int q = 0; q < 4; ++q) thr[q] = 0u;
            const int ntile = (qb + 3) / 32 + 1;
            const unsigned char* KIb = (const unsigned char*)KI;
            auto loadb = [&](i32x8& b, int kt) {
                const int kc = kt < ntile ? kt : ntile - 1;
                const unsigned off = (unsigned)kc * 2048u + (unsigned)lane * 16u;
                const u32x4 k0 = *(const u32x4*)(KIb + off), k1 = *(const u32x4*)(KIb + off + 1024u);
                b = (i32x8){(int)k0.x, (int)k0.y, (int)k0.z, (int)k0.w, (int)k1.x, (int)k1.y, (int)k1.z, (int)k1.w};
            };
            unsigned thv[2];
            auto refresh_thv = [&]() {
#pragma unroll
                for (int sel = 0; sel < 2; ++sel) thv[sel] = hh ? thr[2 * sel + 1] : thr[2 * sel];
            };
            int mycnt[2] = {0, 0};
            int cmaxv = 0;
            unsigned lomask = hh ? 0u : 0xFFFFFFFFu, himask = ~lomask;
            asm volatile("" : "+v"(lomask), "+v"(himask));
            auto prune_while = [&](int limit, int slack, bool force, int seen) {
                if (!force && __ballot(cmaxv > limit) == 0ull) return;
                int kk = TK_K;
                if (!force && mode == 0) { const float rr = 256.0f * (float)seen * inv_p; const int ke = (int)(rr + 5.0f * __builtin_sqrtf(rr) + 8.0f); kk = ke < TK_K ? ke : TK_K; }
                int cnt[4];
#pragma unroll
                for (int q = 0; q < 4; ++q) cnt[q] = __builtin_amdgcn_readlane(mycnt[q >> 1], (q & 1) * 32);
                for (;;) {
                    int qi = -1;
#pragma unroll
                    for (int q = 3; q >= 0; --q) qi = (cnt[q] > limit) ? q : qi;
                    qi = __builtin_amdgcn_readfirstlane(qi);
                    if (qi < 0) break;
                    int nq = 0; unsigned lo = 0u;
#pragma unroll
                    for (int q = 0; q < 4; ++q) { nq = (q == qi) ? cnt[q] : nq; lo = (q == qi) ? thr[q] : lo; }
                    int cn;
                    const unsigned T = topk_prune(cb + qi * TK_CAP, nq, kk, slack, lane, cn);
#pragma unroll
                    for (int q = 0; q < 4; ++q) if (q == qi) { cnt[q] = __builtin_amdgcn_readfirstlane(cn); thr[q] = __builtin_amdgcn_readfirstlane(T); }
                }
                refresh_thv();
                cmaxv = 0;
#pragma unroll
                for (int sel = 0; sel < 2; ++sel) { mycnt[sel] = hh ? cnt[2 * sel + 1] : cnt[2 * sel]; cmaxv = mycnt[sel] > cmaxv ? mycnt[sel] : cmaxv; }
            };
            refresh_thv();
            auto headsum = [&](const f32x16& acc, float& s0, float& s1) {
                unsigned xa, xb, xc, xd, xe, xf, xg, xh;
                asm("s_nop 15\n\ts_nop 3\n\t"
                    "v_cvt_pk_bf16_f32 %0, %8, %9 clamp\n\t"
                    "v_cvt_pk_bf16_f32 %1, %10, %11 clamp\n\t"
                    "v_cvt_pk_bf16_f32 %2, %12, %13 clamp\n\t"
                    "v_cvt_pk_bf16_f32 %3, %14, %15 clamp\n\t"
                    "v_cvt_pk_bf16_f32 %4, %16, %17 clamp\n\t"
                    "v_cvt_pk_bf16_f32 %5, %18, %19 clamp\n\t"
                    "v_cvt_pk_bf16_f32 %6, %20, %21 clamp\n\t"
                    "v_cvt_pk_bf16_f32 %7, %22, %23 clamp\n\t"
                    "s_nop 1"
                    : "=&v"(xa), "=&v"(xb), "=&v"(xc), "=&v"(xd), "=&v"(xe), "=&v"(xf), "=&v"(xg), "=&v"(xh)
                    : "v"(acc[0]), "v"(acc[1]), "v"(acc[2]), "v"(acc[3]), "v"(acc[4]), "v"(acc[5]), "v"(acc[6]), "v"(acc[7]),
                      "v"(acc[8]), "v"(acc[9]), "v"(acc[10]), "v"(acc[11]), "v"(acc[12]), "v"(acc[13]), "v"(acc[14]), "v"(acc[15]));
                const u32x4 x0 = {xa, xb, xc, xd}, x1 = {xe, xf, xg, xh};
                f32x16 y;
#pragma unroll
                for (int q = 0; q < 16; ++q) y[q] = 0.f;
                y = __builtin_amdgcn_mfma_f32_32x32x16_bf16(__builtin_bit_cast(bf16x8, wf[0]), __builtin_bit_cast(bf16x8, x0), y, 0, 0, 0);
                y = __builtin_amdgcn_mfma_f32_32x32x16_bf16(__builtin_bit_cast(bf16x8, wf[1]), __builtin_bit_cast(bf16x8, x1), y, 0, 0, 0);
                s0 = y[0]; s1 = y[1];
            };
            auto append = [&](float s0, float s1, int kt, bool masked) {
                const int key = kt * 32 + r;
#pragma unroll
                for (int sel = 0; sel < 2; ++sel) {
                    const float s = sel ? s1 : s0;
                    const int ql = 2 * sel;
                    const unsigned comp = (fkey(s) & 0xFFFFC000u) | (unsigned)(16383 - key);
                    bool pass = comp > thv[sel];
                    if (masked) pass = pass && (key <= qb + 2 * sel + hh);
                    const unsigned long long m = __ballot(pass);
                    const unsigned lo = (unsigned)m, hi = (unsigned)(m >> 32);
                    const unsigned mlo = lo & lomask;
                    const int pos = __builtin_amdgcn_mbcnt_hi(hi, __builtin_amdgcn_mbcnt_lo(mlo, mycnt[sel]));
                    if (pass) cb[(ql + hh) * TK_CAP + pos] = comp;
                    const unsigned mine = mlo | (hi & himask);
                    mycnt[sel] += __builtin_popcount(mine);
                    cmaxv = mycnt[sel] > cmaxv ? mycnt[sel] : cmaxv;
                }
            };
            auto step2 = [&](i32x8& bA, i32x8& bB, int kt) {
                if (kt + 1 < ntile) {
                    f32x16 accA, accB;
#pragma unroll
                    for (int q = 0; q < 16; ++q) { accA[q] = 0.f; accB[q] = 0.f; }
                    accA = __builtin_amdgcn_mfma_scale_f32_32x32x64_f8f6f4(a8, bA, accA, 0, 0, 0, 115, 0, 115);
                    accB = __builtin_amdgcn_mfma_scale_f32_32x32x64_f8f6f4(a8, bB, accB, 0, 0, 0, 115, 0, 115);
                    float a0, a1, c0, c1;
                    headsum(accA, a0, a1);
                    headsum(accB, c0, c1);
                    append(a0, a1, kt, false);
                    if (kt + 1 == ntile - 1) append(c0, c1, kt + 1, true); else append(c0, c1, kt + 1, false);
                    prune_while(TK_CAP - 64, 32, false, (kt + 2) * 32);
                } else if (kt < ntile) {
                    f32x16 accA;
#pragma unroll
                    for (int q = 0; q < 16; ++q) accA[q] = 0.f;
                    accA = __builtin_amdgcn_mfma_scale_f32_32x32x64_f8f6f4(a8, bA, accA, 0, 0, 0, 115, 0, 115);
                    float a0, a1;
                    headsum(accA, a0, a1);
                    append(a0, a1, kt, true);
                }
                loadb(bA, kt + 8); loadb(bB, kt + 9);
            };
            i32x8 b0, b1, b2, b3, b4, b5, b6, b7;
            loadb(b0, 0); loadb(b1, 1); loadb(b2, 2); loadb(b3, 3); loadb(b4, 4); loadb(b5, 5); loadb(b6, 6); loadb(b7, 7);
            for (int kt = 0; kt < ntile; kt += 8) { step2(b0, b1, kt); step2(b2, b3, kt + 2); step2(b4, b5, kt + 4); step2(b6, b7, kt + 6); }
            prune_while(TK_K, 0, true, 0);
            if (mode == 0) {
                bool bad = false;
#pragma unroll
                for (int qi = 0; qi < 4; ++qi) {
                    const int c = __builtin_amdgcn_readlane(mycnt[qi >> 1], (qi & 1) * 32);
                    bad = bad || (c < TK_K && c < qb + qi + 1);
                }
                if (bad) { mode = 1; continue; }
            }
#pragma unroll
            for (int qi = 0; qi < 4; ++qi) {
                const int c = __builtin_amdgcn_readlane(mycnt[qi >> 1], (qi & 1) * 32), qg = qb + qi;
#pragma unroll
                for (int i = 0; i < 4; ++i) { const int pos = i * 64 + lane; const unsigned v = cb[qi * TK_CAP + pos]; SEL[(size_t)qg * 256 + pos] = (pos < c) ? (unsigned short)(16383u - (v & 0x3FFFu)) : (unsigned short)0; }
                if (lane == 0) SELC[qg] = c;
            }
            mode = 0; ++half;
        }
    }
}

typedef float f32x2d_t __attribute__((ext_vector_type(2)));
DEVI float dpp_f(float x, const int ctrl_sel) {
    const int xi = __builtin_bit_cast(int, x);
    const int y = (ctrl_sel == 0) ? __builtin_amdgcn_update_dpp(0, xi, 0xB1, 0xF, 0xF, true) : (ctrl_sel == 1) ? __builtin_amdgcn_update_dpp(0, xi, 0x4E, 0xF, 0xF, true)
                                                                                                              : __builtin_amdgcn_update_dpp(0, xi, 0x141, 0xF, 0xF, true);
    return __builtin_bit_cast(float, y);
}
DEVI float red8_max(float v) { v = fmaxf(v, dpp_f(v, 0)); v = fmaxf(v, dpp_f(v, 1)); v = fmaxf(v, dpp_f(v, 2)); return v; }
DEVI float red8_sum(float v) { v += dpp_f(v, 0); v += dpp_f(v, 1); v += dpp_f(v, 2); return v; }
DEVI int dpp_i(int x, const int ctrl_sel) {
    return (ctrl_sel == 0) ? __builtin_amdgcn_update_dpp(0, x, 0xB1, 0xF, 0xF, true) : (ctrl_sel == 1) ? __builtin_amdgcn_update_dpp(0, x, 0x4E, 0xF, 0xF, true) : __builtin_amdgcn_update_dpp(0, x, 0x141, 0xF, 0xF, true);
}
DEVI int xreduce8i(const int (&part)[8], int lane) {
    int r4[4], r2[2];
#pragma unroll
    for (int j = 0; j < 4; ++j) { const int mine = (lane & 4) ? part[j + 4] : part[j], send = (lane & 4) ? part[j] : part[j + 4]; r4[j] = mine + dpp_i(send, 2); }
#pragma unroll
    for (int j = 0; j < 2; ++j) { const int mine = (lane & 2) ? r4[j + 2] : r4[j], send = (lane & 2) ? r4[j] : r4[j + 2]; r2[j] = mine + dpp_i(send, 1); }
    const int mine = (lane & 1) ? r2[1] : r2[0], send = (lane & 1) ? r2[0] : r2[1];
    return mine + dpp_i(send, 0);
}
DEVI float xreduce8(const float (&part)[8], int lane) {
    float r4[4], r2[2];
#pragma unroll
    for (int j = 0; j < 4; ++j) { const float mine = (lane & 4) ? part[j + 4] : part[j], send = (lane & 4) ? part[j] : part[j + 4]; r4[j] = mine + dpp_f(send, 2); }
#pragma unroll
    for (int j = 0; j < 2; ++j) { const float mine = (lane & 2) ? r4[j + 2] : r4[j], send = (lane & 2) ? r4[j] : r4[j + 2]; r2[j] = mine + dpp_f(send, 1); }
    const float mine = (lane & 1) ? r2[1] : r2[0], send = (lane & 1) ? r2[0] : r2[1];
    return mine + dpp_f(send, 0);
}
template <bool LT>
static DEVI void sa_item(const Params& p, unsigned char* wl, const unsigned short* skl, int grp, int h, int lane) {
    const unsigned char* Pb = (const unsigned char*)(p.ws + WS_P);
    const unsigned short* SEL = (const unsigned short*)(p.ws + WS_SEL);
    const int* SELC = (const int*)(p.ws + WS_SELC);
    unsigned short* sI = (unsigned short*)wl;
    float* sP = (float*)(wl + 4096);
    const int qi = lane >> 3, d8 = lane & 7, t0 = grp * 8, t = t0 + qi;
    const int n = SELC[t], nlast = __builtin_amdgcn_readfirstlane(SELC[t0 + 7]);
    const int ng = (nlast + 7) >> 3;
#pragma unroll
    for (int i = 0; i < 4; ++i) *(u32x4*)(wl + i * 1024 + lane * 16) = *(const u32x4*)((const unsigned char*)(SEL + (size_t)t0 * 256) + i * 1024 + lane * 16);
    asm volatile("" ::: "memory");
    const u32x4 qv = *(const u32x4*)(Pb + (unsigned)t * (LDP * 2) + (C_DQ + h * 64 + d8 * 8) * 2);
    const float qf[8] = {bflo(qv.x), bfhi(qv.x), bflo(qv.y), bfhi(qv.y), bflo(qv.z), bfhi(qv.z), bflo(qv.w), bfhi(qv.w)};
    float qa = 0.f;
#pragma unroll
    for (int i = 0; i < 8; ++i) qa = fmaxf(qa, fabsf(qf[i]));
    qa = red8_max(qa);
    const float qinv = qa > 0.f ? 127.0f / qa : 0.f, qs = qa * (1.4426950408889634f / 127.0f);
    int qq[8];
#pragma unroll
    for (int i = 0; i < 8; ++i) qq[i] = (int)__builtin_rintf(qf[i] * qinv);
    const int q8a = (qq[0] & 0xff) | ((qq[1] & 0xff) << 8) | ((qq[2] & 0xff) << 16) | (qq[3] << 24), q8b = (qq[4] & 0xff) | ((qq[5] & 0xff) << 8) | ((qq[6] & 0xff) << 16) | (qq[7] << 24);
    const unsigned short* skg = (const unsigned short*)(p.ws + WS_SKT) + (size_t)h * S;
    const unsigned kvoff = 4096u + h * 128 + d8 * 16;
    float m = -__builtin_inff(), lsum = 0.f;
    f32x2d_t acc2[4] = {{0.f, 0.f}, {0.f, 0.f}, {0.f, 0.f}, {0.f, 0.f}};
    auto compute2 = [&](const u32x4 (&kv)[16], const unsigned (&sk)[2], int g) {
        int part[2][8];
#pragma unroll
        for (int j = 0; j < 16; ++j) part[j >> 3][j & 7] = __builtin_amdgcn_sdot4(q8b, (int)kv[j].y, __builtin_amdgcn_sdot4(q8a, (int)kv[j].x, 0, false), false);
        float s0 = (float)xreduce8i(part[0], lane) * (qs * bflo(sk[0])), s1 = (float)xreduce8i(part[1], lane) * (qs * bflo(sk[1]));
        s0 = (g * 8 + d8 < n) ? s0 : -__builtin_inff();
        s1 = (g * 8 + 8 + d8 < n) ? s1 : -__builtin_inff();
        const float mnew = fmaxf(m, red8_max(fmaxf(s0, s1)));
        const float sc = __builtin_amdgcn_exp2f(m - mnew), pm0 = __builtin_amdgcn_exp2f(s0 - mnew), pm1 = __builtin_amdgcn_exp2f(s1 - mnew);
        lsum = lsum * sc + red8_sum(pm0 + pm1);
        m = mnew;
        asm volatile("" ::: "memory");
        sP[lane] = pm0; sP[64 + lane] = pm1;
        asm volatile("" ::: "memory");
        const f32x4 p0 = *(const f32x4*)(sP + qi * 8), p1 = *(const f32x4*)(sP + qi * 8 + 4), p2 = *(const f32x4*)(sP + 64 + qi * 8), p3 = *(const f32x4*)(sP + 64 + qi * 8 + 4);
        asm volatile("" ::: "memory");
        const f32x2d_t sc2 = {sc, sc};
#pragma unroll
        for (int i = 0; i < 4; ++i) acc2[i] = acc2[i] * sc2;
#pragma unroll
        for (int j = 0; j < 16; ++j) {
            const float pj = (j < 4) ? p0[j & 3] : (j < 8) ? p1[j & 3] : (j < 12) ? p2[j & 3] : p3[j & 3];
            const f32x2d_t pj2 = {pj, pj};
            const int v0 = (int)kv[j].z, v1 = (int)kv[j].w;
            acc2[0] = pj2 * __builtin_amdgcn_cvt_pk_f32_fp8(v0, false) + acc2[0];
            acc2[1] = pj2 * __builtin_amdgcn_cvt_pk_f32_fp8(v0, true) + acc2[1];
            acc2[2] = pj2 * __builtin_amdgcn_cvt_pk_f32_fp8(v1, false) + acc2[2];
            acc2[3] = pj2 * __builtin_amdgcn_cvt_pk_f32_fp8(v1, true) + acc2[3];
        }
    };
    auto issue2 = [&](u32x4 (&dst)[16], unsigned (&sk)[2], int g) {
        const int ga = g < 31 ? g : 30;
        const unsigned ia = sI[qi * 256 + ga * 8 + d8], ib = sI[qi * 256 + ga * 8 + 8 + d8];
        sk[0] = LT ? skl[ia] : skg[ia]; sk[1] = LT ? skl[ib] : skg[ib];
        const u32x4 iw = *(const u32x4*)(sI + qi * 256 + ga * 8), ix = *(const u32x4*)(sI + qi * 256 + ga * 8 + 8);
        const unsigned id[16] = {iw.x & 0xffffu, iw.x >> 16, iw.y & 0xffffu, iw.y >> 16, iw.z & 0xffffu, iw.z >> 16, iw.w & 0xffffu, iw.w >> 16,
                                 ix.x & 0xffffu, ix.x >> 16, ix.y & 0xffffu, ix.y >> 16, ix.z & 0xffffu, ix.z >> 16, ix.w & 0xffffu, ix.w >> 16};
#pragma unroll
        for (int j = 0; j < 16; ++j) dst[j] = *(const u32x4*)(Pb + (id[j] * (unsigned)(LDP * 2) + kvoff));
    };
    u32x4 kvX[16], kvY[16]; unsigned skX[2], skY[2];
    issue2(kvX, skX, 0); issue2(kvY, skY, 2 < ng ? 2 : 0);
    for (int g = 0; g < ng; g += 4) {
        compute2(kvX, skX, g);
        issue2(kvX, skX, g + 4 < ng ? g + 4 : 0);
        if (g + 2 < ng) compute2(kvY, skY, g + 2);
        issue2(kvY, skY, g + 6 < ng ? g + 6 : 0);
    }
    const float inv = 0.125f / lsum;
    const float inv8 = inv * F8_OB;
    u32x2 w; w.x = pk4_fp8(acc2[0].x * inv8, acc2[0].y * inv8, acc2[1].x * inv8, acc2[1].y * inv8); w.y = pk4_fp8(acc2[2].x * inv8, acc2[2].y * inv8, acc2[3].x * inv8, acc2[3].y * inv8);
    *(u32x2*)(p.ws + WS_P + (size_t)t * (LDP * 2) + B_OB8 + h * 64 + d8 * 8) = w;
    asm volatile("" ::: "memory");
}
static DEVI void sa_phase(const Params& p, unsigned char* lds, int tid) {
    const int lane = tid & 63, wave = __builtin_amdgcn_readfirstlane(tid >> 6);
    unsigned char* wl = lds + wave * 4608;
    if ((gridDim.x & 7) == 0) {
        const int h = blockIdx.x & 7, lw = (blockIdx.x >> 3) * 4 + wave, nlw = (gridDim.x >> 3) * 4;
        unsigned short* skl = (unsigned short*)(lds + 20480);
        const unsigned char* skg = p.ws + WS_SKT + (size_t)h * S * 2;
#pragma unroll
        for (int i = 0; i < 8; ++i) *(u32x4*)((unsigned char*)skl + i * 4096 + tid * 16) = *(const u32x4*)(skg + i * 4096 + tid * 16);
        __syncthreads();
        for (int grp = lw; grp < S / 8; grp += nlw) sa_item<true>(p, wl, skl, grp, h, lane);
    } else {
        const int gw = blockIdx.x * 4 + wave, nw = gridDim.x * 4;
        for (int it = gw; it < S; it += nw) sa_item<false>(p, wl, nullptr, it >> 3, it & 7, lane);
    }
}

template <bool WITH_DSA>
static DEVI void phaseM1(const Params& p, unsigned char* lds, int tid) {
    const int lane = tid & 63, wave = __builtin_amdgcn_readfirstlane(tid >> 6), wr = wave >> 1, wc = wave & 1, lr = lane & 15, lq = lane >> 4;
    const bf16_t* P = (const bf16_t*)(p.ws + WS_P);
    const unsigned char* wpg = (const unsigned char*)p.out + DO_WPG;
    const unsigned char* wpd = (const unsigned char*)p.out + DO_WPD;
    unsigned char* mix = (unsigned char*)p.out + DO_H;
    const unsigned char* Pb = (const unsigned char*)P;
    for (int i = blockIdx.x; i < 1024; i += gridDim.x) {
        const int xcd = i & 7, j = i >> 3, nt = j & 7, mt = xcd * 16 + (j >> 3);
        int lre = lr; asm volatile("" : "+v"(lre));
        f32x4 acc[4][4]; zero_acc(acc);
        const unsigned char* ap[4]; const unsigned char* bp[4];
#pragma unroll
        for (int q = 0; q < 4; ++q) {
            ap[q] = Pb + (size_t)(mt * 128 + q * 32 + (tid >> 3)) * (LDP * 2) + B_OA8 + gemm_kcb(tid);
            bp[q] = wpg + (size_t)(nt * 128 + bperm(q * 32 + (tid >> 3))) * 512 + gemm_kcb(tid);
        }
        gemm128f8(acc, ap, bp, 4, lds, tid);
        {
            const float ds = 1.0f / (F8_OA * F8_WP);
#pragma unroll
            for (int m = 0; m < 4; ++m)
#pragma unroll
                for (int n = 0; n < 4; ++n) acc[m][n] = acc[m][n] * ds;
        }
#pragma unroll
        for (int m = 0; m < 4; ++m) {
            const unsigned goff = (unsigned)(mt * 128 + wr * 64 + m * 16 + lre) * (unsigned)(LDP * 2) + (unsigned)(C_BG * 2 + nt * 128 + wc * 64 + lq * 16);
            const u32x4 g = *(const u32x4*)(Pb + goff);
#pragma unroll
            for (int n = 0; n < 4; ++n) {
                const f32x2d_t g01 = __builtin_amdgcn_cvt_pk_f32_fp8((int)g[n], false), g23 = __builtin_amdgcn_cvt_pk_f32_fp8((int)g[n], true);
                acc[m][n][0] *= g01.x * (1.0f / F8_G); acc[m][n][1] *= g01.y * (1.0f / F8_G); acc[m][n][2] *= g23.x * (1.0f / F8_G); acc[m][n][3] *= g23.y * (1.0f / F8_G);
            }
        }
        if (WITH_DSA) {
            u32x4 park[4];
#pragma unroll
            for (int m = 0; m < 4; ++m)
#pragma unroll
                for (int n = 0; n < 4; ++n) park[m][n] = pk4_fp8(acc[m][n][0] * 64.0f, acc[m][n][1] * 64.0f, acc[m][n][2] * 64.0f, acc[m][n][3] * 64.0f);
            zero_acc(acc);
            {
                const unsigned char* ap2[4]; const unsigned char* bp2[4];
#pragma unroll
                for (int q = 0; q < 4; ++q) { ap2[q] = ap[q] + (B_OB8 - B_OA8); bp2[q] = bp[q] + (wpd - wpg); }
                gemm128f8(acc, ap2, bp2, 4, lds, tid);
            }
            {
                const float ds = 1.0f / (F8_OB * F8_WP);
#pragma unroll
                for (int m = 0; m < 4; ++m)
#pragma unroll
                    for (int n = 0; n < 4; ++n) acc[m][n] = acc[m][n] * ds;
            }
#pragma unroll
            for (int m = 0; m < 4; ++m) {
                const unsigned goff = (unsigned)(mt * 128 + wr * 64 + m * 16 + lre) * (unsigned)(LDP * 2) + (unsigned)(C_BG * 2 + 1024 + nt * 128 + wc * 64 + lq * 16);
                const u32x4 g = *(const u32x4*)(Pb + goff);
#pragma unroll
                for (int n = 0; n < 4; ++n) {
                    const f32x2d_t g01 = __builtin_amdgcn_cvt_pk_f32_fp8((int)g[n], false), g23 = __builtin_amdgcn_cvt_pk_f32_fp8((int)g[n], true);
                    const f32x2d_t k01 = __builtin_amdgcn_cvt_pk_f32_fp8((int)park[m][n], false), k23 = __builtin_amdgcn_cvt_pk_f32_fp8((int)park[m][n], true);
                    acc[m][n][0] = acc[m][n][0] * (g01.x * (1.0f / F8_G)) + k01.x * (1.0f / 64.0f); acc[m][n][1] = acc[m][n][1] * (g01.y * (1.0f / F8_G)) + k01.y * (1.0f / 64.0f);
                    acc[m][n][2] = acc[m][n][2] * (g23.x * (1.0f / F8_G)) + k23.x * (1.0f / 64.0f); acc[m][n][3] = acc[m][n][3] * (g23.y * (1.0f / F8_G)) + k23.y * (1.0f / 64.0f);
                }
            }
        }
#pragma unroll
        for (int m = 0; m < 4; ++m) {
            const unsigned row = (unsigned)(mt * 128 + wr * 64 + m * 16 + lre);
            u32x4 w;
            w.x = pk4_fp8(acc[m][0][0] * F8_MIX, acc[m][0][1] * F8_MIX, acc[m][0][2] * F8_MIX, acc[m][0][3] * F8_MIX);
            w.y = pk4_fp8(acc[m][1][0] * F8_MIX, acc[m][1][1] * F8_MIX, acc[m][1][2] * F8_MIX, acc[m][1][3] * F8_MIX);
            w.z = pk4_fp8(acc[m][2][0] * F8_MIX, acc[m][2][1] * F8_MIX, acc[m][2][2] * F8_MIX, acc[m][2][3] * F8_MIX);
            w.w = pk4_fp8(acc[m][3][0] * F8_MIX, acc[m][3][1] * F8_MIX, acc[m][3][2] * F8_MIX, acc[m][3][3] * F8_MIX);
            *(u32x4*)(mix + (row * 1024u + (unsigned)(nt * 128 + wc * 64 + lq * 16))) = w;
        }
    }
}

static DEVI void phaseM2(const Params& p, unsigned char* lds, int tid) {
    const int lane = tid & 63, wave = __builtin_amdgcn_readfirstlane(tid >> 6), wr = wave >> 1, wc = wave & 1, lr = lane & 15, lq = lane >> 4;
    bf16_t* P = (bf16_t*)(p.ws + WS_P);
    const unsigned char* wo = (const unsigned char*)p.out + DO_WOUT;
    const unsigned char* mix = (const unsigned char*)p.out + DO_H;
    for (int i = blockIdx.x; i < 1024; i += gridDim.x) {
        const int xcd = i & 7, j = i >> 3, nt = j & 7, mt = xcd * 16 + (j >> 3);
        const unsigned char* ap[4]; const unsigned char* bp[4];
#pragma unroll
        for (int q = 0; q < 4; ++q) {
            ap[q] = mix + (size_t)(mt * 128 + q * 32 + (tid >> 3)) * 1024 + gemm_kcb(tid);
            bp[q] = wo + (size_t)(nt * 128 + bperm(q * 32 + (tid >> 3))) * 1024 + gemm_kcb(tid);
        }
        f32x4 acc[4][4]; zero_acc(acc);
        gemm128f8(acc, ap, bp, 8, lds, tid);
        {
            const float ds = 1.0f / (F8_MIX * F8_WO);
#pragma unroll
            for (int m = 0; m < 4; ++m)
#pragma unroll
                for (int n = 0; n < 4; ++n) acc[m][n] = acc[m][n] * ds;
        }
#pragma unroll
        for (int m = 0; m < 4; ++m) {
            unsigned char* orow = (unsigned char*)P + (size_t)(mt * 128 + wr * 64 + m * 16 + lr) * (LDP * 2);
            u32x4 w;
            w.x = pk4_fp8(acc[m][0][0] * F8_O, acc[m][0][1] * F8_O, acc[m][0][2] * F8_O, acc[m][0][3] * F8_O);
            w.y = pk4_fp8(acc[m][1][0] * F8_O, acc[m][1][1] * F8_O, acc[m][1][2] * F8_O, acc[m][1][3] * F8_O);
            w.z = pk4_fp8(acc[m][2][0] * F8_O, acc[m][2][1] * F8_O, acc[m][2][2] * F8_O, acc[m][2][3] * F8_O);
            w.w = pk4_fp8(acc[m][3][0] * F8_O, acc[m][3][1] * F8_O, acc[m][3][2] * F8_O, acc[m][3][3] * F8_O);
            __builtin_nontemporal_store(w, (u32x4*)(orow + nt * 128 + wc * 64 + lq * 16));
        }
    }
}

static DEVI void phaseM3(const Params& p, unsigned char* lds, int tid) {
    const int lane = tid & 63, wave = __builtin_amdgcn_readfirstlane(tid >> 6);
    const float* mod = (const float*)(p.ws + WS_MOD);
    const bf16_t* WrTb = (const bf16_t*)(p.ws + WS_WRT);
    bf16_t* P = (bf16_t*)(p.ws + WS_P);
    int* LIST = (int*)(p.ws + WS_LIST);
    float* CW = (float*)(p.ws + WS_CW);
    int* cnt = (int*)(p.ws + WS_CNT);
    unsigned char* HT = lds;
    float* PART = (float*)(lds + 32768);
    float* LG = (float*)(lds + 32768 + 9216);
    float* BIAS = LG + 16 * 48;
    float* A2S = BIAS + 64;
    float* B2S = A2S + 1024;
    if (tid < 36) BIAS[tid] = tid < 4 ? p.b_rg[tid] : p.b_re[tid - 4];
    *(f32x4*)(A2S + tid * 4) = *(const f32x4*)(p.g_pre_ffn + tid * 4) * (*(const f32x4*)(mod + 4096 + tid * 4) + 1.0f);
    *(f32x4*)(B2S + tid * 4) = *(const f32x4*)(mod + 3072 + tid * 4);
    const int lr = lane & 15, lq = lane >> 4;
    bf16x8 wf[8][3];
#pragma unroll
    for (int s = 0; s < 8; ++s)
#pragma unroll
        for (int c = 0; c < 3; ++c) wf[s][c] = *(const bf16x8*)(WrTb + (size_t)(c * 16 + lr) * 1024 + wave * 256 + s * 32 + lq * 8);
    f32x4 G1[4];
#pragma unroll
    for (int i = 0; i < 4; ++i) {
        const int c0 = i * 256 + lane * 4;
        G1[i] = *(const f32x4*)(mod + 2048 + c0) * *(const f32x4*)(p.g_post_mix + c0);
    }
    for (int it = blockIdx.x; it < S / 16; it += gridDim.x) {
        __syncthreads();
#pragma unroll 1
        for (int rp = 0; rp < 2; ++rp) {
            int ob[2][4]; f32x4 xv[2][4]; float ss[2] = {0.f, 0.f};
#pragma unroll
            for (int q = 0; q < 2; ++q) {
                const size_t r = (size_t)it * 16 + wave * 4 + rp * 2 + q;
                const unsigned char* orow = (const unsigned char*)P + r * (LDP * 2);
#pragma unroll
                for (int i = 0; i < 4; ++i) {
                    ob[q][i] = __builtin_nontemporal_load((const int*)(orow + i * 256 + lane * 4));
                    xv[q][i] = __builtin_nontemporal_load((const f32x4*)(p.x + r * D + i * 256 + lane * 4));
                }
            }
#pragma unroll
            for (int q = 0; q < 2; ++q) {
#pragma unroll
                for (int i = 0; i < 4; ++i) { const f32x2d_t oa = __builtin_amdgcn_cvt_pk_f32_fp8(ob[q][i], false), oc = __builtin_amdgcn_cvt_pk_f32_fp8(ob[q][i], true); ss[q] += (oa.x * oa.x + oa.y * oa.y) + (oc.x * oc.x + oc.y * oc.y); }
                ss[q] = wave_sum(ss[q]);
            }
#pragma unroll
            for (int q = 0; q < 2; ++q) {
                const int rloc = wave * 4 + rp * 2 + q; const size_t r = (size_t)it * 16 + rloc;
                const float rstd1 = rsqrtf(ss[q] * (1.0f / (1024.0f * F8_O * F8_O)) + EPS) * (1.0f / F8_O);
                float s2 = 0.f;
#pragma unroll
                for (int i = 0; i < 4; ++i) {
                    const int c0 = i * 256 + lane * 4;
                    const f32x2d_t oa = __builtin_amdgcn_cvt_pk_f32_fp8(ob[q][i], false), oc = __builtin_amdgcn_cvt_pk_f32_fp8(ob[q][i], true);
                    const f32x4 ov = {oa.x, oa.y, oc.x, oc.y};
                    xv[q][i] = xv[q][i] + G1[i] * ov * rstd1;
                    { u32x2 wm; wm.x = pk2(xv[q][i][0], xv[q][i][1]); wm.y = pk2(xv[q][i][2], xv[q][i][3]); __builtin_nontemporal_store(wm, (u32x2*)(P + r * LDP + C_XM + c0)); }
                    s2 += (xv[q][i][0] * xv[q][i][0] + xv[q][i][1] * xv[q][i][1]) + (xv[q][i][2] * xv[q][i][2] + xv[q][i][3] * xv[q][i][3]); }
                s2 = wave_sum(s2);
                const float rstd2 = rsqrtf(s2 * (1.0f / 1024.0f) + EPS);
#pragma unroll
                for (int i = 0; i < 4; ++i) {
                    const int c0 = i * 256 + lane * 4;
                    const f32x4 y = xv[q][i] * rstd2 * *(const f32x4*)(A2S + c0) + *(const f32x4*)(B2S + c0);
                    u32x2 w; w.x = pk2(y[0], y[1]); w.y = pk2(y[2], y[3]);
                    __builtin_nontemporal_store(pk4_fp8(y[0] * F8_H2, y[1] * F8_H2, y[2] * F8_H2, y[3] * F8_H2), (unsigned*)((unsigned char*)P + r * (LDP * 2) + C_H2 * 2 + c0));
                    *(u32x2*)(HT + rloc * 2048 + (((c0 >> 3) ^ (rloc & 7)) << 4) + (c0 & 7) * 2) = w;
                }
            }
        }
        __syncthreads();
        f32x4 acc[3];
#pragma unroll
        for (int c = 0; c < 3; ++c) acc[c] = (f32x4){0.f, 0.f, 0.f, 0.f};
#pragma unroll
        for (int s = 0; s < 8; ++s) {
            const bf16x8 av = *(const bf16x8*)(HT + lr * 2048 + (((wave * 32 + s * 4 + lq) ^ (lr & 7)) << 4));
#pragma unroll
            for (int c = 0; c < 3; ++c) acc[c] = __builtin_amdgcn_mfma_f32_16x16x32_bf16(wf[s][c], av, acc[c], 0, 0, 0);
        }
        if (wave > 0) {
#pragma unroll
            for (int c = 0; c < 3; ++c) *(f32x4*)(PART + ((wave - 1) * 3 + c) * 256 + lane * 4) = acc[c];
        }
        __syncthreads();
        if (wave == 0) {
#pragma unroll
            for (int c = 0; c < 3; ++c) {
                f32x4 t = acc[c];
#pragma unroll
                for (int w = 0; w < 3; ++w) t = t + *(const f32x4*)(PART + (w * 3 + c) * 256 + lane * 4);
                *(f32x4*)(LG + lr * 48 + c * 16 + lq * 4) = t;
            }
            asm volatile("" ::: "memory");
            if (lane < 16) {
                const int t = it * 16 + lane;
                const float* lg = LG + lane * 48;
                float gl[4];
#pragma unroll
                for (int q = 0; q < 4; ++q) gl[q] = lg[q] + BIAS[q];
                int gs = 0; float gm = gl[0];
#pragma unroll
                for (int q = 1; q < 4; ++q) if (gl[q] > gm) { gm = gl[q]; gs = q; }
                float gsum = 0.f;
#pragma unroll
                for (int q = 0; q < 4; ++q) gsum += __expf(gl[q] - gm);
                const float pg = 1.0f / gsum;
                float el[8];
#pragma unroll
                for (int q = 0; q < 8; ++q) el[q] = lg[4 + gs * 8 + q] + BIAS[4 + gs * 8 + q];
                int i0 = 0; float m0 = el[0];
#pragma unroll
                for (int q = 1; q < 8; ++q) if (el[q] > m0) { m0 = el[q]; i0 = q; }
                int i1 = 0; float m1 = -3.0e38f;
#pragma unroll
                for (int q = 0; q < 8; ++q) if (q != i0 && el[q] > m1) { m1 = el[q]; i1 = q; }
                const float e1 = __expf(m1 - m0);
                const float w0 = pg / (1.0f + e1), w1 = pg * e1 / (1.0f + e1);
                const int ea = gs * 8 + i0, eb = gs * 8 + i1;
                const int sa = atomicAdd(&cnt[ea * 32], 1), sb = atomicAdd(&cnt[eb * 32], 1);
                CW[t * 2] = w0; CW[t * 2 + 1] = w1;
                LIST[(size_t)ea * S + sa] = t * 2; LIST[(size_t)eb * S + sb] = t * 2 + 1;
            }
        }
    }
}

DEVI bool moe_find_tile(const int* cl, int tile, int& e, int& j, int& base, int& ne) {
    int acc_t = 0, acc_r = 0; bool found = false; e = 0; j = 0; base = 0; ne = 0;
#pragma unroll 8
    for (int q = 0; q < NEXP; ++q) {
        const int c = cl[q], tq = (c + 127) >> 7;
        if (!found && tile < acc_t + tq) { found = true; e = q; j = tile - acc_t; base = acc_r; ne = c; }
        acc_t += tq; acc_r += c;
    }
    return found;
}
DEVI const int* moe_stage_counts(const Params& p, unsigned char* lds, int tid) {
    int* cl = (int*)(lds + 65536);
    __syncthreads();
    if (tid < NEXP) cl[tid] = ((const int*)(p.ws + WS_CNT))[tid * 32];
    __syncthreads();
    return cl;
}

static DEVI void phaseE1(const Params& p, unsigned char* lds, int tid) {
    const int lane = tid & 63, wave = __builtin_amdgcn_readfirstlane(tid >> 6), wr = wave >> 1, wc = wave & 1, lr = lane & 15, lq = lane >> 4;
    const bf16_t* P = (const bf16_t*)(p.ws + WS_P);
    const int* LIST = (const int*)(p.ws + WS_LIST);
    const float* CW = (const float*)(p.ws + WS_CW);
    const int* cnt = moe_stage_counts(p, lds, tid);
    unsigned char* ACT8 = p.ws + WS_SEL;
    for (int it = blockIdx.x;; it += gridDim.x) {
        int e, j, base, ne;
        const bool ok = moe_find_tile(cnt, it >> 2, e, j, base, ne);
        if (!ok) break;
        const int nt = it & 3;
        const unsigned char* wgu = p.ws + WS_WGU + (size_t)e * 512 * 1024;
        const unsigned char* ap[4]; const unsigned char* bp[4];
#pragma unroll
        for (int q = 0; q < 4; ++q) {
            int slot = j * 128 + q * 32 + (tid >> 3); slot = slot < ne ? slot : 0;
            const int tok = LIST[(size_t)e * S + slot] >> 1;
            ap[q] = (const unsigned char*)P + (size_t)tok * (LDP * 2) + C_H2 * 2 + gemm_kcb(tid);
            bp[q] = wgu + (size_t)(nt * 128 + q * 32 + (tid >> 3)) * 1024 + gemm_kcb(tid);
        }
        float cwm[4];
#pragma unroll
        for (int m = 0; m < 4; ++m) { const int slot = j * 128 + wr * 64 + m * 16 + lr; cwm[m] = CW[LIST[(size_t)e * S + (slot < ne ? slot : 0)]]; }
        f32x4 acc[4][4]; zero_acc(acc);
        gemm128f8(acc, ap, bp, 8, lds, tid);
#pragma unroll
        for (int m = 0; m < 4; ++m) {
            const int slot = j * 128 + wr * 64 + m * 16 + lr;
            if (slot < ne) {
                const float cw = cwm[m];
#pragma unroll
                for (int hp = 0; hp < 2; ++hp) {
                    const f32x4 g = acc[m][hp * 2] * (1.0f / (F8_H2 * F8_WGU)), u = acc[m][hp * 2 + 1] * (1.0f / (F8_H2 * F8_WGU));
                    const float sc = cw * F8_ACT;
                    const unsigned w = pk4_fp8(siluf_(g[0]) * u[0] * sc, siluf_(g[1]) * u[1] * sc, siluf_(g[2]) * u[2] * sc, siluf_(g[3]) * u[3] * sc);
                    __hip_atomic_store((unsigned*)(ACT8 + (size_t)(base + slot) * 256 + nt * 64 + wc * 32 + hp * 16 + lq * 4), w, __ATOMIC_RELAXED, __HIP_MEMORY_SCOPE_AGENT);
                }
            }
        }
        asm volatile("s_waitcnt vmcnt(0)" ::: "memory");
        __syncthreads();
        if (tid == 0) __hip_atomic_fetch_add((unsigned*)(p.ws + WS_CNT) + 1024 + (it >> 2), 1u, __ATOMIC_RELAXED, __HIP_MEMORY_SCOPE_AGENT);
    }
}

static DEVI void phaseE2(const Params& p, unsigned char* lds, int tid) {
    const int lane = tid & 63, wave = __builtin_amdgcn_readfirstlane(tid >> 6), wr = wave >> 1, wc = wave & 1, lr = lane & 15, lq = lane >> 4;
    bf16_t* P = (bf16_t*)(p.ws + WS_P);
    const int* LIST = (const int*)(p.ws + WS_LIST);
    const int* cnt = (const int*)(lds + 65536);
    const unsigned char* ACT8 = p.ws + WS_SEL;
    unsigned* queue = (unsigned*)(p.ws + WS_CNT) + 2;
    volatile int* qslot = (volatile int*)(lds + 65536 + 256);
    __syncthreads();
    if (tid == 0) *qslot = (int)__hip_atomic_fetch_add(queue, 1u, __ATOMIC_RELAXED, __HIP_MEMORY_SCOPE_AGENT);
    __syncthreads();
    int it = *qslot;
    for (;;) {
        int e, j, base, ne;
        const bool ok = moe_find_tile(cnt, it >> 3, e, j, base, ne);
        if (!ok) break;
        unsigned nxt = 0;
        if (tid == 0) {
            nxt = __hip_atomic_fetch_add(queue, 1u, __ATOMIC_RELAXED, __HIP_MEMORY_SCOPE_AGENT);
            while (__hip_atomic_load((unsigned*)(p.ws + WS_CNT) + 1024 + (it >> 3), __ATOMIC_RELAXED, __HIP_MEMORY_SCOPE_AGENT) < 4u) __builtin_amdgcn_s_sleep(2);
            __builtin_amdgcn_fence(__ATOMIC_ACQUIRE, "agent");
        }
        __syncthreads();
        const int nt = it & 7;
        const unsigned char* wd = p.ws + WS_WD + (size_t)e * 1024 * 256;
        const unsigned char* ap[4]; const unsigned char* bp[4];
#pragma unroll
        for (int q = 0; q < 4; ++q) {
            int slot = j * 128 + q * 32 + (tid >> 3); slot = slot < ne ? slot : 0;
            ap[q] = ACT8 + (size_t)(base + slot) * 256 + gemm_kcb(tid);
            bp[q] = wd + (size_t)(nt * 128 + bperm(q * 32 + (tid >> 3))) * 256 + gemm_kcb(tid);
        }
        int entm[4];
#pragma unroll
        for (int m = 0; m < 4; ++m) { const int slot = j * 128 + wr * 64 + m * 16 + lr; entm[m] = LIST[(size_t)e * S + (slot < ne ? slot : 0)]; }
        f32x4 acc[4][4]; zero_acc(acc);
        gemm128f8(acc, ap, bp, 2, lds, tid);
#pragma unroll
        for (int m = 0; m < 4; ++m) {
            const int slot = j * 128 + wr * 64 + m * 16 + lr;
            if (slot < ne) {
                const int ent = entm[m];
                unsigned char* yrow = (unsigned char*)P + (size_t)(ent >> 1) * (LDP * 2) + C_Y * 2 + (ent & 1) * 1024;
                const float ys = F8_Y / (F8_ACT * F8_WD);
                u32x4 w;
                w.x = pk4_fp8(acc[m][0][0] * ys, acc[m][0][1] * ys, acc[m][0][2] * ys, acc[m][0][3] * ys);
                w.y = pk4_fp8(acc[m][1][0] * ys, acc[m][1][1] * ys, acc[m][1][2] * ys, acc[m][1][3] * ys);
                w.z = pk4_fp8(acc[m][2][0] * ys, acc[m][2][1] * ys, acc[m][2][2] * ys, acc[m][2][3] * ys);
                w.w = pk4_fp8(acc[m][3][0] * ys, acc[m][3][1] * ys, acc[m][3][2] * ys, acc[m][3][3] * ys);
                *(u32x4*)(yrow + nt * 128 + wc * 64 + lq * 16) = w;
            }
        }
        if (tid == 0) *qslot = (int)nxt;
        __syncthreads();
        it = *qslot;
    }
}

static DEVI void phaseF(const Params& p, int tid) {
    const int lane = tid & 63, gw = blockIdx.x * 4 + __builtin_amdgcn_readfirstlane(tid >> 6), nw = gridDim.x * 4;
    const float* mod = (const float*)(p.ws + WS_MOD);
    const bf16_t* P = (const bf16_t*)(p.ws + WS_P);
    f32x4 G[4];
#pragma unroll
    for (int i = 0; i < 4; ++i) { const int c0 = i * 256 + lane * 4; G[i] = *(const f32x4*)(mod + 5120 + c0) * *(const f32x4*)(p.g_post_ffn + c0); }
    for (int r0 = gw; r0 < S; r0 += 2 * nw) {
        f32x4 y[2][4], xm[2][4]; float ss[2] = {0.f, 0.f};
#pragma unroll
        for (int q = 0; q < 2; ++q) {
            const int r = (r0 + q * nw < S) ? r0 + q * nw : r0;
#pragma unroll
            for (int i = 0; i < 4; ++i) {
                const unsigned char* yb = (const unsigned char*)P + (size_t)r * (LDP * 2) + C_Y * 2 + i * 256 + lane * 4;
                const int a = __builtin_nontemporal_load((const int*)yb), b = __builtin_nontemporal_load((const int*)(yb + 1024));
                const f32x2d_t a01 = __builtin_amdgcn_cvt_pk_f32_fp8(a, false), a23 = __builtin_amdgcn_cvt_pk_f32_fp8(a, true), b01 = __builtin_amdgcn_cvt_pk_f32_fp8(b, false), b23 = __builtin_amdgcn_cvt_pk_f32_fp8(b, true);
                const u32x2 xb = __builtin_nontemporal_load((const u32x2*)(P + (size_t)r * LDP + C_XM + i * 256 + lane * 4));
                xm[q][i] = (f32x4){bflo(xb.x), bfhi(xb.x), bflo(xb.y), bfhi(xb.y)};
                y[q][i][0] = (a01.x + b01.x) * (1.0f / F8_Y); y[q][i][1] = (a01.y + b01.y) * (1.0f / F8_Y); y[q][i][2] = (a23.x + b23.x) * (1.0f / F8_Y); y[q][i][3] = (a23.y + b23.y) * (1.0f / F8_Y);
            }
        }
#pragma unroll
        for (int q = 0; q < 2; ++q) {
#pragma unroll
            for (int i = 0; i < 4; ++i) ss[q] += (y[q][i][0] * y[q][i][0] + y[q][i][1] * y[q][i][1]) + (y[q][i][2] * y[q][i][2] + y[q][i][3] * y[q][i][3]);
            ss[q] = wave_sum(ss[q]);
        }
#pragma unroll
        for (int q = 0; q < 2; ++q) {
            const int r = r0 + q * nw;
            if (r < S) {
                const float rstd = rsqrtf(ss[q] * (1.0f / 1024.0f) + EPS);
#pragma unroll
                for (int i = 0; i < 4; ++i) __builtin_nontemporal_store(xm[q][i] + G[i] * y[q][i] * rstd, (f32x4*)(p.out + (size_t)r * D + i * 256 + lane * 4));
            }
        }
    }
}

#ifndef STOP_AFTER_MIXER
#define STOP_AFTER_MIXER 0
#endif
__global__ void __launch_bounds__(NT, 2) mega(Params p) {
    __shared__ __attribute__((aligned(16))) unsigned char lds[LDS_BYTES];
    cg::grid_group grid = cg::this_grid();
    int tid = threadIdx.x;
    const int wv64 = __builtin_amdgcn_readfirstlane(tid & ~63);
#define FRESH_TID() do { int l_; asm volatile("v_mbcnt_lo_u32_b32 %0, -1, 0\n\tv_mbcnt_hi_u32_b32 %0, -1, %0" : "=v"(l_)); tid = wv64 + l_; } while (0)
    uint4* xb_words = (uint4*)(lds + LDS_BYTES - 16);
    if (tid == 0) *xb_words = make_uint4(0u, 0u, 0u, 0u);
    __syncthreads();
    if (p.out == nullptr) grid.sync();
    XcdBarrier xb = xcd_barrier_post((unsigned*)(p.ws + WS_BAR), (volatile LAS unsigned*)xb_words);
    FRESH_TID();
    phase0(p, lds, tid);
    FRESH_TID();
    phase1(p, tid);
    xcd_barrier(xb);
    FRESH_TID();
    phase2(p, lds, tid);
    xcd_barrier(xb);
    FRESH_TID();
    for (int it = blockIdx.x; it < 1024; it += gridDim.x) gla_item<false>(p, it, lds, tid);
    __syncthreads();
    FRESH_TID();
    topk_phase(p, lds, tid);
    xcd_barrier(xb);
    FRESH_TID();
    gla_scan(p, tid);
    FRESH_TID();
    sa_phase(p, lds, tid);
    xcd_barrier(xb);
    FRESH_TID();
    for (int it = blockIdx.x; it < 1024; it += gridDim.x) gla_item<true>(p, it, lds, tid);
    xcd_barrier(xb);
    FRESH_TID();
    phaseM1<true>(p, lds, tid);
    xcd_barrier(xb);
    FRESH_TID();
    phaseM2(p, lds, tid);
    xcd_barrier(xb);
    FRESH_TID();
    phaseM3(p, lds, tid);
    xcd_barrier(xb);
    FRESH_TID();
    phaseE1(p, lds, tid);
    FRESH_TID();
    phaseE2(p, lds, tid);
    xcd_barrier(xb);
    FRESH_TID();
    phaseF(p, tid);
}

extern "C" void kernel_launch(void* const* d_in, const int* in_sizes, int n_in, void* d_out, int out_size, void* d_ws, size_t ws_size, hipStream_t stream) {
    static int grid_blocks = 0;
    if (!grid_blocks) {
        int dev = 0, cus = 0, per_cu = 0;
        hipGetDevice(&dev);
        hipDeviceGetAttribute(&cus, hipDeviceAttributeMultiprocessorCount, dev);
        hipOccupancyMaxActiveBlocksPerMultiprocessor(&per_cu, mega, NT, 0);
        if (per_cu > 2) per_cu = 2;
        if (per_cu < 1) per_cu = 1;
        grid_blocks = cus * per_cu;
        if (ws_size < WS_END) fprintf(stderr, "kernel_launch: workspace too small: %zu < %zu\n", ws_size, (size_t)WS_END);
    }
    Params p{};
    p.x = (const float*)d_in[0]; p.c = (const float*)d_in[1]; p.pos = (const int*)d_in[2]; p.w_ada = (const float*)d_in[3]; p.b_ada = (const float*)d_in[4];
    p.g_pre_mix = (const float*)d_in[5]; p.g_post_mix = (const float*)d_in[6]; p.g_pre_ffn = (const float*)d_in[7]; p.g_post_ffn = (const float*)d_in[8];
    p.w_in = (const float*)d_in[9]; p.w_gla_a2 = (const float*)d_in[10]; p.b_gla_a = (const float*)d_in[11]; p.g_gla_out = (const float*)d_in[12]; p.g_idx_k = (const float*)d_in[13];
    p.w_proj_gla = (const float*)d_in[14]; p.w_proj_dsa = (const float*)d_in[15]; p.w_out = (const float*)d_in[16];
    p.w_rg = (const float*)d_in[17]; p.b_rg = (const float*)d_in[18]; p.w_re = (const float*)d_in[19]; p.b_re = (const float*)d_in[20];
    p.w_eg = (const float*)d_in[21]; p.w_eu = (const float*)d_in[22]; p.w_ed = (const float*)d_in[23];
    p.out = (float*)d_out; p.ws = (unsigned char*)d_ws;
    (void)hipMemsetAsync((unsigned char*)d_ws + WS_CNT, 0, 8192 + XCD_BAR_WORDS * 4, stream);
    void* args[] = {&p};
    hipError_t e = hipLaunchCooperativeKernel((void*)mega, dim3(grid_blocks), dim3(NT), args, 0, stream);
    if (e != hipSuccess) fprintf(stderr, "cooperative launch failed: %s (grid %d)\n", hipGetErrorString(e), grid_blocks);
}
```
